# Optimizing an MI355X kernel written in HIP

```python
import math
import jax, jax.numpy as jnp
from jax import lax
import numpy as np

D_MODEL = 1024
BATCH = 8
SEQ = 2048
DEPTH = 1

N_META = 16
GRID_W = 64
NA_WIDTH = D_MODEL // 2
S5_WIDTH = D_MODEL - NA_WIDTH
MIX_WIDTH = NA_WIDTH + S5_WIDTH
NA_HEAD_DIM = 64
NA_HEADS = NA_WIDTH // NA_HEAD_DIM
NA_KH_MAX = 8
NA_KW = 16
S5_GROUP = 16
S5_GROUPS = S5_WIDTH // S5_GROUP
S5_STATE = 64
D_FF = ((8 * D_MODEL // 3 + 127) // 128) * 128
RMS_EPS = 1e-6
DT_MIN = 1e-3
DT_MAX = 1e-1
NEG_INF = -1e30

kernel_name = "hybrid_natten_s5_macaron_block"


def rms_norm(x, g):
    xf = x.astype(jnp.float32)
    y = xf * lax.rsqrt(jnp.mean(xf * xf, axis=-1, keepdims=True) + RMS_EPS)
    return (y * g.astype(jnp.float32)).astype(x.dtype)


def swiglu(x, w_gate, w_up, w_down):
    return (jax.nn.silu(x @ w_gate) * (x @ w_up)) @ w_down


def _ssm_combine(e1, e2):
    a1, b1 = e1
    a2, b2 = e2
    return a1 * a2, a2 * b1 + b2


def s5_mixer(u, lam_re, lam_im, log_dt, b_re, b_im, c_re, c_im, d_skip, w_glu, b_glu):
    f32 = jnp.float32
    bsz, length, _ = u.shape
    uf = u.astype(f32).reshape(bsz, length, S5_GROUPS, S5_GROUP)
    uc = uf.astype(jnp.complex64)
    y = uf * d_skip.astype(f32).reshape(S5_GROUPS, S5_GROUP)
    for direction in range(2):
        lam = lax.complex(lam_re[direction].astype(f32), lam_im[direction].astype(f32))
        dt = jnp.exp(log_dt[direction].astype(f32))[:, None]
        lam_bar = jnp.exp(lam * dt)
        b = lax.complex(b_re[direction].astype(f32), b_im[direction].astype(f32))
        b_bar = ((lam_bar - 1.0) / lam)[..., None] * b
        bu = jnp.einsum('blgh,gph->blgp', uc, b_bar)
        a = jnp.broadcast_to(lam_bar, bu.shape)
        _, states = lax.associative_scan(_ssm_combine, (a, bu), axis=1, reverse=(direction == 1))
        y = y + jnp.einsum('blgp,ghp->blgh', jnp.real(states), c_re[direction].astype(f32)) \
              - jnp.einsum('blgp,ghp->blgh', jnp.imag(states), c_im[direction].astype(f32))
    y = jax.nn.gelu(y.reshape(bsz, length, S5_WIDTH))
    y = y * jax.nn.sigmoid(y @ w_glu.astype(f32) + b_glu.astype(f32))
    return y.astype(u.dtype)


def neighbourhood_attention(q, k, v, rpb):
    f32 = jnp.float32
    bsz, length = q.shape[0], q.shape[1]
    n_tok = length - N_META
    rows = n_tok // GRID_W
    kh = min(NA_KH_MAX, rows)
    kw = NA_KW
    scale = NA_HEAD_DIM ** -0.5
    qm, qt = q[:, :N_META], q[:, N_META:]
    km, kt = k[:, :N_META], k[:, N_META:]
    vm, vt = v[:, :N_META], v[:, N_META:]

    r = np.arange(rows)
    row_start = np.clip(r - kh // 2, 0, rows - kh)
    row_idx = row_start[:, None] + np.arange(kh)[None, :]
    c = np.arange(GRID_W)
    col_start = np.clip(c - kw // 2, 0, GRID_W - kw)
    col_in = (c[None, :] >= col_start[:, None]) & (c[None, :] < col_start[:, None] + kw)
    dr = row_idx - r[:, None] + NA_KH_MAX - 1
    dc = np.clip(c[None, :] - c[:, None] + kw - 1, 0, 2 * kw - 2)
    bias = rpb.astype(f32)[:, dr[:, None, :, None], dc[None, :, None, :]]
    bias = jnp.where(jnp.asarray(col_in)[None, None, :, None, :], bias, NEG_INF)
    bias = bias.reshape(NA_HEADS, rows, GRID_W, kh * GRID_W)

    qg = qt.reshape(bsz, rows, GRID_W, NA_HEADS, NA_HEAD_DIM)
    kg = kt.reshape(bsz, rows, GRID_W, NA_HEADS, NA_HEAD_DIM)
    vg = vt.reshape(bsz, rows, GRID_W, NA_HEADS, NA_HEAD_DIM)
    kb = jnp.take(kg, row_idx, axis=1).reshape(bsz, rows, kh * GRID_W, NA_HEADS, NA_HEAD_DIM)
    vb = jnp.take(vg, row_idx, axis=1).reshape(bsz, rows, kh * GRID_W, NA_HEADS, NA_HEAD_DIM)

    s_loc = jnp.einsum('brqhd,brkhd->bhrqk', qg, kb, preferred_element_type=f32) * scale + bias
    s_meta = jnp.einsum('brqhd,bmhd->bhrqm', qg, km, preferred_element_type=f32) * scale
    p = jax.nn.softmax(jnp.concatenate([s_loc, s_meta], axis=-1), axis=-1)
    p_loc, p_meta = p[..., :kh * GRID_W], p[..., kh * GRID_W:]
    o_tok = jnp.einsum('bhrqk,brkhd->brqhd', p_loc.astype(v.dtype), vb) \
          + jnp.einsum('bhrqm,bmhd->brqhd', p_meta.astype(v.dtype), vm)
    o_tok = o_tok.reshape(bsz, n_tok, NA_HEADS, NA_HEAD_DIM)

    s_mm = jnp.einsum('bqhd,bmhd->bhqm', qm, km, preferred_element_type=f32) * scale
    o_meta = jnp.einsum('bhqm,bmhd->bqhd', jax.nn.softmax(s_mm, axis=-1).astype(v.dtype), vm)
    return jnp.concatenate([o_meta, o_tok], axis=1).reshape(bsz, length, NA_WIDTH)


def setup_inputs(seed: int = 0) -> dict:
    key = jax.random.key(seed)
    ks = iter(jax.random.split(key, 40))
    f32 = jnp.float32

    def nrm(shape, scale):
        return jax.random.normal(next(ks), shape, f32) * scale

    def gain(shape):
        return 1.0 + 0.02 * jax.random.normal(next(ks), shape, f32)

    L = DEPTH
    n_idx = jnp.arange(S5_STATE, dtype=f32)
    inp = {}
    inp['x'] = nrm((BATCH, SEQ, D_MODEL), 1.0)
    inp['meta_tokens'] = nrm((N_META, D_MODEL), 1.0)
    inp['ffn1_pre_g'] = gain((L, D_MODEL))
    inp['ffn1_post_g'] = gain((L, D_MODEL))
    inp['ffn1_w_gate'] = nrm((L, D_MODEL, D_FF), D_MODEL ** -0.5)
    inp['ffn1_w_up'] = nrm((L, D_MODEL, D_FF), D_MODEL ** -0.5)
    inp['ffn1_w_down'] = nrm((L, D_FF, D_MODEL), D_FF ** -0.5)
    inp['mix_pre_g'] = gain((L, D_MODEL))
    inp['w_in'] = nrm((L, D_MODEL, 3 * NA_WIDTH + S5_WIDTH), D_MODEL ** -0.5)
    inp['na_rpb'] = nrm((L, NA_HEADS, 2 * NA_KH_MAX - 1, 2 * NA_KW - 1), 0.05)
    inp['s5_lam_re'] = -0.5 + nrm((L, 2, S5_GROUPS, S5_STATE), 0.01)
    inp['s5_lam_im'] = math.pi * n_idx + nrm((L, 2, S5_GROUPS, S5_STATE), 0.01)
    inp['s5_log_dt'] = jax.random.uniform(next(ks), (L, 2, S5_GROUPS), f32, math.log(DT_MIN), math.log(DT_MAX))
    inp['s5_b_re'] = nrm((L, 2, S5_GROUPS, S5_STATE, S5_GROUP), (0.5 / S5_GROUP) ** 0.5)
    inp['s5_b_im'] = nrm((L, 2, S5_GROUPS, S5_STATE, S5_GROUP), (0.5 / S5_GROUP) ** 0.5)
    inp['s5_c_re'] = nrm((L, 2, S5_GROUPS, S5_GROUP, S5_STATE), (0.5 / S5_STATE) ** 0.5)
    inp['s5_c_im'] = nrm((L, 2, S5_GROUPS, S5_GROUP, S5_STATE), (0.5 / S5_STATE) ** 0.5)
    inp['s5_d'] = nrm((L, S5_WIDTH), 1.0)
    inp['s5_w_glu'] = nrm((L, S5_WIDTH, S5_WIDTH), S5_WIDTH ** -0.5)
    inp['s5_b_glu'] = nrm((L, S5_WIDTH), 0.02)
    inp['na_out_g'] = gain((L, NA_WIDTH))
    inp['s5_out_g'] = gain((L, S5_WIDTH))
    inp['w_out'] = nrm((L, MIX_WIDTH, D_MODEL), MIX_WIDTH ** -0.5)
    inp['mix_post_g'] = gain((L, D_MODEL))
    inp['ffn2_pre_g'] = gain((L, D_MODEL))
    inp['ffn2_post_g'] = gain((L, D_MODEL))
    inp['ffn2_w_gate'] = nrm((L, D_MODEL, D_FF), D_MODEL ** -0.5)
    inp['ffn2_w_up'] = nrm((L, D_MODEL, D_FF), D_MODEL ** -0.5)
    inp['ffn2_w_down'] = nrm((L, D_FF, D_MODEL), D_FF ** -0.5)
    inp['final_g'] = gain((L, D_MODEL))
    return inp


def reference(x, meta_tokens, ffn1_pre_g, ffn1_post_g, ffn1_w_gate, ffn1_w_up, ffn1_w_down,
              mix_pre_g, w_in, na_rpb, s5_lam_re, s5_lam_im, s5_log_dt, s5_b_re, s5_b_im,
              s5_c_re, s5_c_im, s5_d, s5_w_glu, s5_b_glu, na_out_g, s5_out_g, w_out, mix_post_g,
              ffn2_pre_g, ffn2_post_g, ffn2_w_gate, ffn2_w_up, ffn2_w_down, final_g):
    bsz = x.shape[0]
    meta = jnp.broadcast_to(meta_tokens.astype(x.dtype)[None], (bsz, N_META, D_MODEL))
    h = jnp.concatenate([meta, x], axis=1)
    length = h.shape[1]
    for i in range(DEPTH):
        f = swiglu(rms_norm(h, ffn1_pre_g[i]), ffn1_w_gate[i], ffn1_w_up[i], ffn1_w_down[i])
        h = h + 0.5 * rms_norm(f, ffn1_post_g[i])
        a = rms_norm(h, mix_pre_g[i])
        proj = a @ w_in[i]
        q = proj[..., :NA_WIDTH].reshape(bsz, length, NA_HEADS, NA_HEAD_DIM)
        k = proj[..., NA_WIDTH:2 * NA_WIDTH].reshape(bsz, length, NA_HEADS, NA_HEAD_DIM)
        v = proj[..., 2 * NA_WIDTH:3 * NA_WIDTH].reshape(bsz, length, NA_HEADS, NA_HEAD_DIM)
        u = proj[..., 3 * NA_WIDTH:]
        o_na = neighbourhood_attention(q, k, v, na_rpb[i])
        o_s5 = s5_mixer(u, s5_lam_re[i], s5_lam_im[i], s5_log_dt[i], s5_b_re[i], s5_b_im[i],
                        s5_c_re[i], s5_c_im[i], s5_d[i], s5_w_glu[i], s5_b_glu[i])
        mix = jnp.concatenate([rms_norm(o_na, na_out_g[i]), rms_norm(o_s5, s5_out_g[i])], axis=-1) @ w_out[i]
        h = h + rms_norm(mix, mix_post_g[i])
        f = swiglu(rms_norm(h, ffn2_pre_g[i]), ffn2_w_gate[i], ffn2_w_up[i], ffn2_w_down[i])
        h = h + 0.5 * rms_norm(f, ffn2_post_g[i])
        h = rms_norm(h, final_g[i])
    return h[:, N_META:]
```

```cpp
#include <hip/hip_runtime.h>
#include <hip/hip_cooperative_groups.h>
#include <cstdio>
#include <cstdint>
namespace cg = cooperative_groups;
namespace pg8 {
#define PG8_LAS __attribute__((address_space(3)))
typedef unsigned short bf16_t;
typedef short bf16x8 __attribute__((ext_vector_type(8)));
typedef float f32x4 __attribute__((ext_vector_type(4)));
typedef unsigned u32x4 __attribute__((ext_vector_type(4)));
constexpr int BM = 256, BK = 64, HALF = 128, HTB = HALF * BK * 2  , STAGE_BYTES = 8 * HTB, NXCD = 8, WGM = 8;

__host__ __device__ __forceinline__ int lds_byte(int r, int c) { const int st = (r >> 4) * 2 + (c >> 5), rr = r & 15, cc = c & 31, ob = rr * 64 + cc * 2; return st * 1024 + (ob ^ (((ob >> 9) & 1) << 5)); }
__host__ __device__ __forceinline__ void stage_rc(int b, int& R, int& C) { const int st = b / 1024, sb = b % 1024, swz = sb ^ (((sb >> 9) & 1) << 5); R = (st >> 1) * 16 + swz / 64; C = (st & 1) * 32 + (swz % 64) / 2; }
__host__ __device__ __forceinline__ int perm32(int rho) { const int n = rho >> 4, i = rho & 15; return 8 * (i >> 2) + 4 * n + (i & 3); }

struct Unit { int pm, pn; };
struct Gemm { const bf16_t* A; const bf16_t* Bt; int M, N, K; };

struct StaticOrder {
    int nM, nN, nwg, G, c;
    __host__ __device__ void init(int M, int N, int G_, int c_) { nM = M / BM; nN = N / BM; nwg = nM * nN; G = G_; c = c_; }
    __host__ __device__ bool next(int i, Unit& u) const {
        const long L = (long)i * G + c; if (L >= nwg) return false;
        int wgid = (int)L; { const int q = nwg / NXCD, r = nwg % NXCD, xcd = wgid % NXCD, off = wgid / NXCD; wgid = (xcd < r ? xcd * (q + 1) : r * (q + 1) + (xcd - r) * q) + off; }
        const int nig = WGM * nN, gid = wgid / nig, fm = gid * WGM, gsz = (nM - fm) < WGM ? (nM - fm) : WGM;
        u.pm = fm + ((wgid % nig) % gsz); u.pn = (wgid % nig) / gsz; return true;
    }
    __device__ __forceinline__ void a_ready(const Unit&) const {}
    __device__ __forceinline__ void done(const Unit&) const {}
};

__device__ __forceinline__ unsigned cvt_pk_bf16(float lo, float hi) { unsigned r; asm volatile("v_cvt_pk_bf16_f32 %0, %1, %2" : "=v"(r) : "v"(lo), "v"(hi)); return r; }
typedef float f32x2 __attribute__((ext_vector_type(2)));
__device__ __forceinline__ f32x2 gelu_pk(f32x2 v) {
    const f32x2 av = __builtin_elementwise_abs(v), d = av * 0.2316418882f + 1.0f;
    f32x2 t; t.x = __builtin_amdgcn_rcpf(d.x); t.y = __builtin_amdgcn_rcpf(d.y);
    f32x2 q = t * 0.5307027145f + (-0.7265760135f); q = q * t + 0.7107068705f; q = q * t + (-0.142248368f); q = q * t + 0.127414796f; q = q * t;
    const f32x2 s = (v * v) * (-0.72134752044f);
    f32x2 e; e.x = __builtin_amdgcn_exp2f(s.x); e.y = __builtin_amdgcn_exp2f(s.y);
    const f32x2 m = v * (q * e), r = v - m;
    f32x2 o; o.x = v.x < 0.f ? m.x : r.x; o.y = v.y < 0.f ? m.y : r.y; return o;
}

template <int ACT  > struct EpiBf16 {
    static constexpr bool PERM = true, AFTER_DRAIN = false; static_assert(ACT == 0 || ACT == 1, "EpiBf16: ACT is 0 (none) or 1 (gelu_pk)");
    bf16_t* O; int ldc; const float* bias; int split_cols; size_t split_stride; float scale0;
    __device__ __forceinline__ void operator()(const f32x4 (&acc)[2][2][4][2], const Unit& u, int wr, int wc, int fr, int fq) const {
        const int row0 = u.pm * BM + wr * 64 + fr; int colt = u.pn * BM; bf16_t* base = O;
        float sc = 1.f; if (split_cols) { const int t = colt / split_cols; base += (size_t)t * split_stride; colt -= t * split_cols; if (t == 0) sc = scale0; }
        const int col0 = colt + wc * 32 + 8 * fq, bcol0 = u.pn * BM + wc * 32 + 8 * fq;
        f32x4 bv[2][2];
#pragma unroll
        for (int bj = 0; bj < 2; ++bj)
#pragma unroll
            for (int n = 0; n < 2; ++n) bv[bj][n] = bias ? *(const f32x4*)(bias + bcol0 + bj * HALF + 4 * n) : (f32x4){0.f, 0.f, 0.f, 0.f};
#pragma unroll
        for (int ai = 0; ai < 2; ++ai)
#pragma unroll
            for (int m = 0; m < 4; ++m) { bf16_t* rowp = base + (size_t)(row0 + ai * HALF + m * 16) * ldc + col0;
#pragma unroll
                for (int bj = 0; bj < 2; ++bj) { f32x4 v0 = acc[ai][bj][m][0] + bv[bj][0], v1 = acc[ai][bj][m][1] + bv[bj][1];
                    if (ACT == 1) { f32x2 a = gelu_pk((f32x2){v0[0], v0[1]}), b = gelu_pk((f32x2){v0[2], v0[3]}), c = gelu_pk((f32x2){v1[0], v1[1]}), d = gelu_pk((f32x2){v1[2], v1[3]});
                        v0 = (f32x4){a.x, a.y, b.x, b.y}; v1 = (f32x4){c.x, c.y, d.x, d.y}; }
                    v0 = v0 * sc; v1 = v1 * sc; u32x4 w; w.x = cvt_pk_bf16(v0[0], v0[1]); w.y = cvt_pk_bf16(v0[2], v0[3]); w.z = cvt_pk_bf16(v1[0], v1[1]); w.w = cvt_pk_bf16(v1[2], v1[3]);
                    *(u32x4*)(rowp + bj * HALF) = w; } }
    }
};
__device__ __forceinline__ float fast_sigmoid(float x) { return __builtin_amdgcn_rcpf(1.0f + __builtin_amdgcn_exp2f(-1.44269504089f * x)); }
struct EpiSwiGLU {
    static constexpr bool PERM = true, AFTER_DRAIN = false;
    bf16_t* O; int ldc;
    __device__ __forceinline__ void operator()(const f32x4 (&acc)[2][2][4][2], const Unit& u, int wr, int wc, int fr, int fq) const {
        const int row0 = u.pm * BM + wr * 64 + fr; const int col0 = u.pn * HALF + wc * 32 + 8 * fq;
#pragma unroll
        for (int ai = 0; ai < 2; ++ai)
#pragma unroll
            for (int m = 0; m < 4; ++m) { bf16_t* rowp = O + (size_t)(row0 + ai * HALF + m * 16) * ldc + col0;
                f32x4 g0 = acc[ai][0][m][0], g1 = acc[ai][0][m][1], u0 = acc[ai][1][m][0], u1 = acc[ai][1][m][1];
                f32x4 v0, v1;
#pragma unroll
                for (int e = 0; e < 4; ++e) { v0[e] = g0[e] * fast_sigmoid(g0[e]) * u0[e]; v1[e] = g1[e] * fast_sigmoid(g1[e]) * u1[e]; }
                u32x4 w; w.x = cvt_pk_bf16(v0[0], v0[1]); w.y = cvt_pk_bf16(v0[2], v0[3]); w.z = cvt_pk_bf16(v1[0], v1[1]); w.w = cvt_pk_bf16(v1[2], v1[3]);
                *(u32x4*)rowp = w; }
    }
};
struct EpiF32 {
    static constexpr bool PERM = false, AFTER_DRAIN = false;
    float* O; int ldc;
    __device__ __forceinline__ void operator()(const f32x4 (&acc)[2][2][4][2], const Unit& u, int wr, int wc, int fr, int fq) const {
        const int row0 = u.pm * BM + wr * 64 + fr; const int col0 = u.pn * BM + wc * 32 + 4 * fq;
#pragma unroll
        for (int ai = 0; ai < 2; ++ai)
#pragma unroll
            for (int m = 0; m < 4; ++m) { float* rowp = O + (size_t)(row0 + ai * HALF + m * 16) * ldc + col0;
#pragma unroll
                for (int bj = 0; bj < 2; ++bj)
#pragma unroll
                    for (int n = 0; n < 2; ++n) *(f32x4*)(rowp + bj * HALF + n * 16) = acc[ai][bj][m][n]; }
    }
};
struct EpiGLU {
    static constexpr bool PERM = true, AFTER_DRAIN = false;
    const bf16_t* Y; int ldy; const float* bias; bf16_t* O; int ldc;
    __device__ __forceinline__ void operator()(const f32x4 (&acc)[2][2][4][2], const Unit& u, int wr, int wc, int fr, int fq) const {
        const int row0 = u.pm * BM + wr * 64 + fr; const int col0 = u.pn * BM + wc * 32 + 8 * fq;
#pragma unroll
        for (int ai = 0; ai < 2; ++ai)
#pragma unroll
            for (int m = 0; m < 4; ++m) { const size_t row = (size_t)(row0 + ai * HALF + m * 16);
#pragma unroll
                for (int bj = 0; bj < 2; ++bj) { const int c = col0 + bj * HALF;
                    const u32x4 yv = *(const u32x4*)(Y + row * ldy + c);
                    const f32x4 b0 = *(const f32x4*)(bias + c), b1 = *(const f32x4*)(bias + c + 4);
                    const f32x4 z0 = acc[ai][bj][m][0] + b0, z1 = acc[ai][bj][m][1] + b1;
                    float y[8]; y[0] = __uint_as_float(yv.x << 16); y[1] = __uint_as_float(yv.x & 0xffff0000u); y[2] = __uint_as_float(yv.y << 16); y[3] = __uint_as_float(yv.y & 0xffff0000u);
                    y[4] = __uint_as_float(yv.z << 16); y[5] = __uint_as_float(yv.z & 0xffff0000u); y[6] = __uint_as_float(yv.w << 16); y[7] = __uint_as_float(yv.w & 0xffff0000u);
                    u32x4 w; w.x = cvt_pk_bf16(y[0] * fast_sigmoid(z0[0]), y[1] * fast_sigmoid(z0[1])); w.y = cvt_pk_bf16(y[2] * fast_sigmoid(z0[2]), y[3] * fast_sigmoid(z0[3]));
                    w.z = cvt_pk_bf16(y[4] * fast_sigmoid(z1[0]), y[5] * fast_sigmoid(z1[1])); w.w = cvt_pk_bf16(y[6] * fast_sigmoid(z1[2]), y[7] * fast_sigmoid(z1[3]));
                    *(u32x4*)(O + row * ldc + c) = w; } }
    }
};
template <class Epi, class Sched, bool ALIGN_EPI = false, bool SP2 = false>
__device__ __forceinline__ void gemm_phase(PG8_LAS unsigned char* lds, const Gemm g, const Sched& S, const Epi& E) {
    const int tid = threadIdx.x, wid = __builtin_amdgcn_readfirstlane(tid >> 6), lane = tid & 63, wr = wid >> 2, wc = wid & 3, fr = lane & 15, fq = lane >> 4;
    const int K = g.K, nt = K / BK;
    unsigned voffA[2], voffB[2];
#pragma unroll
    for (int i = 0; i < 2; ++i) { int R, C; stage_rc(tid * 16 + i * 8192, R, C); const int Rb = Epi::PERM ? ((R & ~31) + perm32(R & 31)) : R;
        voffA[i] = (unsigned)(R * K + C) * 2u; voffB[i] = (unsigned)(Rb * K + C) * 2u; }
    const size_t kstep = (size_t)(BK * 2);
    const size_t hstep = (size_t)HALF * K * 2;
    const size_t tstep = 2 * hstep;
    const unsigned ldsw = (unsigned)wid * 1024u;
    const int aoff = lds_byte(wr * 64 + fr, fq * 8), boff = lds_byte(wc * 32 + fr, fq * 8);
#define PG8_SA(b, h) (((b) * 2 + (h)) * HTB)
#define PG8_SB(b, h) ((4 + (b) * 2 + (h)) * HTB)
#define PG8_STAGE(bufoff, gbase, voff) do { _Pragma("unroll") for (int _i = 0; _i < 2; ++_i) \
        __builtin_amdgcn_global_load_lds((const unsigned*)((const char*)(gbase) + (voff)[_i]), (PG8_LAS unsigned*)(lds + (bufoff) + ldsw + _i * 8192), 16, 0, 0); } while (0)
#define PG8_LDA(dst, b, h) do { _Pragma("unroll") for (int m = 0; m < 4; ++m) _Pragma("unroll") for (int k = 0; k < 2; ++k) dst[m][k] = *(const PG8_LAS bf16x8*)(lds + PG8_SA(b, h) + aoff + m * 2048 + k * 1024); } while (0)
#define PG8_LDB(dst, b, h) do { _Pragma("unroll") for (int n = 0; n < 2; ++n) _Pragma("unroll") for (int k = 0; k < 2; ++k) dst[n][k] = *(const PG8_LAS bf16x8*)(lds + PG8_SB(b, h) + boff + n * 2048 + k * 1024); } while (0)
#define PG8_MMA(ai, bj, At, Bt) do { __builtin_amdgcn_s_setprio(1); _Pragma("unroll") for (int m = 0; m < 4; ++m) _Pragma("unroll") for (int n = 0; n < 2; ++n) _Pragma("unroll") for (int k = 0; k < 2; ++k) \
        acc[ai][bj][m][n] = __builtin_amdgcn_mfma_f32_16x16x32_bf16(Bt[n][k], At[m][k], acc[ai][bj][m][n], 0, 0, 0); __builtin_amdgcn_s_setprio(0); } while (0)
#define PG8_WAIT_V(n) asm volatile("s_waitcnt vmcnt(" #n ")" ::: "memory")
#define PG8_WAIT_L(n) asm volatile("s_waitcnt lgkmcnt(" #n ")" ::: "memory")
#define PG8_BAR __builtin_amdgcn_s_barrier()
#define PG8_SCHED __builtin_amdgcn_sched_barrier(0)
    Unit cur, nxt; int ui = 0;
    if (!S.next(0, cur)) return;
    f32x4 acc[2][2][4][2];
#pragma unroll
    for (int a = 0; a < 2; ++a)
#pragma unroll
        for (int b = 0; b < 2; ++b)
#pragma unroll
            for (int m = 0; m < 4; ++m)
#pragma unroll
                for (int n = 0; n < 2; ++n) acc[a][b][m][n] = (f32x4){0.f, 0.f, 0.f, 0.f};
    bf16x8 At[4][2], B0[2][2], B1[2][2];
    const char* cA = (const char*)g.A + (size_t)cur.pm * tstep; const char* cB = (const char*)g.Bt + (size_t)cur.pn * tstep;
    S.a_ready(cur);
    if constexpr (SP2) {
        PG8_STAGE(PG8_SB(0, 0), cB, voffB); PG8_STAGE(PG8_SB(0, 1), cB + hstep, voffB); PG8_STAGE(PG8_SA(0, 0), cA, voffA); PG8_STAGE(PG8_SA(0, 1), cA + hstep, voffA);
        if (wr == 1) PG8_BAR;
        PG8_WAIT_V(2); PG8_BAR;
        PG8_STAGE(PG8_SB(1, 0), cB + kstep, voffB); PG8_STAGE(PG8_SA(1, 0), cA + kstep, voffA); PG8_STAGE(PG8_SB(1, 1), cB + hstep + kstep, voffB);
        PG8_WAIT_V(6); PG8_BAR;
    } else {
        PG8_STAGE(PG8_SB(0, 0), cB, voffB); PG8_STAGE(PG8_SA(0, 0), cA, voffA); PG8_STAGE(PG8_SB(0, 1), cB + hstep, voffB); PG8_STAGE(PG8_SA(0, 1), cA + hstep, voffA);
        if (wr == 1) PG8_BAR;
        PG8_WAIT_V(4); PG8_BAR;
        PG8_STAGE(PG8_SB(1, 0), cB + kstep, voffB); PG8_STAGE(PG8_SA(1, 0), cA + kstep, voffA); PG8_STAGE(PG8_SB(1, 1), cB + hstep + kstep, voffB);
        PG8_WAIT_V(6); PG8_BAR;
    }
    for (;;) {
        const bool has_next = S.next(ui + 1, nxt);
        const char* nA = has_next ? (const char*)g.A + (size_t)nxt.pm * tstep : cA; const char* nB = has_next ? (const char*)g.Bt + (size_t)nxt.pn * tstep : cB;
        for (int t = 0; t < nt; t += 2) {
            const bool last = (t == nt - 2);
            const char* a1 = cA + (size_t)(t + 1) * kstep;
            const char* a2 = last ? nA : cA + (size_t)(t + 2) * kstep; const char* b2 = last ? nB : cB + (size_t)(t + 2) * kstep;
            const char* a3 = a2 + kstep; const char* b3 = b2 + kstep;
            if (last && has_next) S.a_ready(nxt);
            if constexpr (SP2) {
            PG8_LDB(B0, 0, 0); PG8_LDB(B1, 0, 1); PG8_SCHED; PG8_LDA(At, 0, 0); PG8_STAGE(PG8_SA(1, 1), a1 + hstep, voffA);
            PG8_WAIT_V(8); PG8_WAIT_L(0); PG8_BAR; PG8_MMA(0, 0, At, B0); PG8_MMA(0, 1, At, B1); PG8_BAR; PG8_SCHED;
            PG8_LDA(At, 0, 1); PG8_STAGE(PG8_SB(0, 0), b2, voffB); PG8_STAGE(PG8_SB(0, 1), b2 + hstep, voffB); PG8_STAGE(PG8_SA(0, 0), a2, voffA);
            PG8_WAIT_V(8); PG8_WAIT_L(0); PG8_BAR; PG8_MMA(1, 0, At, B0); PG8_MMA(1, 1, At, B1); PG8_BAR; PG8_SCHED;
            PG8_LDB(B0, 1, 0); PG8_LDB(B1, 1, 1); PG8_SCHED; PG8_LDA(At, 1, 0); PG8_STAGE(PG8_SA(0, 1), a2 + hstep, voffA);
            PG8_WAIT_V(8); PG8_WAIT_L(0); PG8_BAR; PG8_MMA(0, 0, At, B0); PG8_MMA(0, 1, At, B1); PG8_BAR; PG8_SCHED;
            PG8_LDA(At, 1, 1); PG8_STAGE(PG8_SB(1, 0), b3, voffB); PG8_STAGE(PG8_SB(1, 1), b3 + hstep, voffB); PG8_STAGE(PG8_SA(1, 0), a3, voffA);
            PG8_WAIT_V(8); PG8_WAIT_L(0); PG8_BAR; PG8_MMA(1, 0, At, B0); PG8_MMA(1, 1, At, B1); PG8_BAR; PG8_SCHED;
            } else {
            PG8_LDB(B0, 0, 0); PG8_SCHED; PG8_LDA(At, 0, 0); PG8_STAGE(PG8_SA(1, 1), a1 + hstep, voffA);
            PG8_WAIT_L(8); PG8_BAR; PG8_WAIT_L(0); PG8_MMA(0, 0, At, B0); PG8_BAR; PG8_SCHED;
            PG8_LDB(B1, 0, 1); PG8_STAGE(PG8_SB(0, 0), b2, voffB);
            PG8_BAR; PG8_WAIT_L(0); PG8_MMA(0, 1, At, B1); PG8_BAR;
            PG8_LDA(At, 0, 1); PG8_STAGE(PG8_SA(0, 0), a2, voffA);
            PG8_BAR; PG8_WAIT_L(0); PG8_MMA(1, 0, At, B0); PG8_BAR; PG8_SCHED;
            PG8_STAGE(PG8_SB(0, 1), b2 + hstep, voffB);
            PG8_WAIT_V(6); PG8_BAR; PG8_MMA(1, 1, At, B1); PG8_BAR;
            PG8_LDB(B0, 1, 0); PG8_SCHED; PG8_LDA(At, 1, 0); PG8_STAGE(PG8_SA(0, 1), a2 + hstep, voffA);
            PG8_WAIT_L(8); PG8_BAR; PG8_WAIT_L(0); PG8_MMA(0, 0, At, B0); PG8_BAR; PG8_SCHED;
            PG8_LDB(B1, 1, 1); PG8_STAGE(PG8_SB(1, 0), b3, voffB);
            PG8_BAR; PG8_WAIT_L(0); PG8_MMA(0, 1, At, B1); PG8_BAR;
            PG8_LDA(At, 1, 1); PG8_STAGE(PG8_SA(1, 0), a3, voffA);
            PG8_BAR; PG8_WAIT_L(0); PG8_MMA(1, 0, At, B0); PG8_BAR; PG8_SCHED;
            PG8_STAGE(PG8_SB(1, 1), b3 + hstep, voffB);
            PG8_WAIT_V(6); PG8_BAR; PG8_MMA(1, 1, At, B1); PG8_BAR;
            }
        }
        if constexpr (ALIGN_EPI) { if (wr == 0) PG8_BAR; }
        if constexpr (!Epi::AFTER_DRAIN) { E(acc, cur, wr, wc, fr, fq); S.done(cur); }
        if (!has_next) break;
#pragma unroll
        for (int a = 0; a < 2; ++a)
#pragma unroll
            for (int b = 0; b < 2; ++b)
#pragma unroll
                for (int m = 0; m < 4; ++m)
#pragma unroll
                    for (int n = 0; n < 2; ++n) acc[a][b][m][n] = (f32x4){0.f, 0.f, 0.f, 0.f};
        cur = nxt; cA = nA; cB = nB; ++ui;
        if constexpr (ALIGN_EPI) { if (wr == 1) PG8_BAR; }
    }
    PG8_WAIT_V(0);
    if constexpr (!ALIGN_EPI) { if (wr == 0) PG8_BAR; }
    PG8_BAR;
    if constexpr (Epi::AFTER_DRAIN) { E.fused(acc, cur, wr, wc, fr, fq, lds, wid, lane); S.done(cur); }
#undef PG8_SA
#undef PG8_SB
#undef PG8_STAGE
#undef PG8_LDA
#undef PG8_LDB
#undef PG8_MMA
#undef PG8_WAIT_V
#undef PG8_WAIT_L
#undef PG8_BAR
#undef PG8_SCHED
}
}
#define LAS __attribute__((address_space(3)))
typedef unsigned short bf16;
typedef float f32x4 __attribute__((ext_vector_type(4)));
typedef short bf16x8 __attribute__((ext_vector_type(8)));
typedef unsigned v4u __attribute__((ext_vector_type(4)));
typedef unsigned v2u __attribute__((ext_vector_type(2)));
constexpr int DM = 1024, NB = 8, SEQ = 2048, MT = NB * SEQ, DFF = 2816, NG = 32, NCH = 129;
constexpr float RMS_EPS = 1e-6f;
enum { I_X = 0, I_META, I_F1PRE, I_F1POST, I_F1WG, I_F1WU, I_F1WD, I_MIXPRE, I_WIN, I_RPB, I_LRE, I_LIM, I_LOGDT, I_BRE, I_BIM, I_CRE, I_CIM, I_S5D, I_WGLU, I_BGLU,
       I_NAG, I_S5G, I_WOUT, I_MIXPOST, I_F2PRE, I_F2POST, I_F2WG, I_F2WU, I_F2WD, I_FINAL, N_IN };
constexpr size_t KiB = 1024, MiB = 1u << 20;
constexpr size_t WS_META = 1 * MiB;
constexpr size_t OM_A1 = 0, OM_ACT = 32 * KiB, OM_F = 128 * KiB, OM_A2 = 192 * KiB, OM_K = 224 * KiB, OM_U = 240 * KiB, OM_VT = 256 * KiB;
constexpr size_t WS_WGU1 = 2 * MiB, WS_WD1 = 13 * MiB, WS_WQKU = 18 * MiB + 512 * KiB, WS_WV = 21 * MiB + 512 * KiB, WS_WGLU = 22 * MiB + 512 * KiB, WS_WOUT = 23 * MiB,
                 WS_WGU2 = 25 * MiB, WS_WD2 = 36 * MiB, WS_WS = 41 * MiB + 512 * KiB, WS_WY = 45 * MiB + 512 * KiB;
constexpr size_t WS_A = 54 * MiB, WS_H = 86 * MiB, WS_ACT = 150 * MiB;
constexpr size_t WS_Q = 150 * MiB, WS_K = 166 * MiB, WS_U = 182 * MiB, WS_VT = 198 * MiB, WS_YG = 214 * MiB, WS_END = 238 * MiB;
constexpr size_t OUT_S = 0, OUT_XX = 33 * MiB;
constexpr int LDS_BYTES = 147456;
constexpr int NWAVES = 8;

__device__ __forceinline__ unsigned f2bf(float f) { unsigned u = __builtin_bit_cast(unsigned, f); return (u + 0x7fffu + ((u >> 16) & 1u)) >> 16; }
__device__ __forceinline__ unsigned pk2(float lo, float hi) { return f2bf(lo) | (f2bf(hi) << 16); }
__device__ __forceinline__ float bflo(unsigned w) { return __uint_as_float(w << 16); }
__device__ __forceinline__ float bfhi(unsigned w) { return __uint_as_float(w & 0xffff0000u); }
__device__ __forceinline__ float wave_sum(float v) {
#pragma unroll
    for (int o = 1; o < 64; o <<= 1) v += __shfl_xor(v, o);
    return v;
}
__device__ __forceinline__ float dot4(f32x4 a) { return (a.x * a.x + a.y * a.y) + (a.z * a.z + a.w * a.w); }
#define MFMA16(a, b, c) __builtin_amdgcn_mfma_f32_16x16x32_bf16((a), (b), (c), 0, 0, 0)

struct Args { const float* in[N_IN]; float* out; unsigned char* ws; };

__device__ __forceinline__ void tr_item(const float* __restrict__ W, int K, int N, int k0, int n0, bf16* __restrict__ dst, LAS float* scr, int lane) {
#pragma unroll 8
    for (int i = 0; i < 32; ++i) { const int kk = 2 * i + (lane >> 5); scr[kk * 33 + (lane & 31)] = W[(size_t)(k0 + kk) * N + n0 + (lane & 31)]; }
    asm volatile("s_waitcnt lgkmcnt(0)" ::: "memory");
    const int c = lane & 7;
#pragma unroll
    for (int j = 0; j < 4; ++j) { const int n = (lane >> 3) + 8 * j; const LAS float* s = scr + (8 * c) * 33 + n;
        v4u o; o.x = pk2(s[0 * 33], s[1 * 33]); o.y = pk2(s[2 * 33], s[3 * 33]); o.z = pk2(s[4 * 33], s[5 * 33]); o.w = pk2(s[6 * 33], s[7 * 33]);
        *(v4u*)(dst + (size_t)n * K + k0 + 8 * c) = o; }
    asm volatile("s_waitcnt lgkmcnt(0)" ::: "memory");
}
__device__ __forceinline__ void row_norm_bf16(const float* __restrict__ xrow, const float* __restrict__ g, bf16* __restrict__ arow, int lane) {
    f32x4 v[4]; float ss = 0.f;
#pragma unroll
    for (int j = 0; j < 4; ++j) { v[j] = ((const f32x4*)xrow)[lane + 64 * j]; ss += dot4(v[j]); }
    const float r = 1.0f / sqrtf(wave_sum(ss) * (1.0f / DM) + RMS_EPS);
#pragma unroll
    for (int j = 0; j < 4; ++j) { const f32x4 gg = ((const f32x4*)g)[lane + 64 * j]; const f32x4 o = v[j] * r * gg;
        v2u w; w.x = pk2(o.x, o.y); w.y = pk2(o.z, o.w); ((v2u*)arow)[lane + 64 * j] = w; }
}
__device__ __forceinline__ void row_res_norm(const float* base, const float* f, const float* __restrict__ gpost, float resw, float* hout,
                                             const float* __restrict__ gpre, bf16* aout, float* fout, int lane) {
    f32x4 v[4]; float ss = 0.f;
#pragma unroll
    for (int j = 0; j < 4; ++j) { v[j] = ((const f32x4*)f)[lane + 64 * j]; ss += dot4(v[j]); }
    const float r = resw / sqrtf(wave_sum(ss) * (1.0f / DM) + RMS_EPS);
    float s2 = 0.f;
#pragma unroll
    for (int j = 0; j < 4; ++j) { const f32x4 gg = ((const f32x4*)gpost)[lane + 64 * j]; const f32x4 bb = ((const f32x4*)base)[lane + 64 * j];
        v[j] = bb + v[j] * r * gg; s2 += dot4(v[j]); if (hout) ((f32x4*)hout)[lane + 64 * j] = v[j]; }
    const float r2 = 1.0f / sqrtf(wave_sum(s2) * (1.0f / DM) + RMS_EPS);
#pragma unroll
    for (int j = 0; j < 4; ++j) { const f32x4 gg = ((const f32x4*)gpre)[lane + 64 * j]; const f32x4 o = v[j] * r2 * gg;
        if (aout) { v2u w; w.x = pk2(o.x, o.y); w.y = pk2(o.z, o.w); ((v2u*)aout)[lane + 64 * j] = w; }
        if (fout) ((f32x4*)fout)[lane + 64 * j] = o; }
}

__device__ __forceinline__ void s5_prep_group(const Args& a, int g, LAS float* L, int tid) {
    LAS float* PWr = L; LAS float* PWi = PWr + 2176; LAS float* BBr = PWi + 2176; LAS float* BBi = BBr + 2048; LAS float* Cr = BBi + 2048; LAS float* Ci = Cr + 2048; LAS float* KT = Ci + 2048;
    const float* lre = a.in[I_LRE]; const float* lim = a.in[I_LIM]; const float* ldt = a.in[I_LOGDT];
    const float* bre = a.in[I_BRE]; const float* bim = a.in[I_BIM]; const float* cre = a.in[I_CRE]; const float* cim = a.in[I_CIM]; const float* dsk = a.in[I_S5D];
    if (tid < 128) {
        const int dir = tid >> 6, p = tid & 63; const int gi = dir * NG + g;
        const float dt = expf(ldt[gi]); const float lr = lre[gi * 64 + p], li = lim[gi * 64 + p];
        for (int k = 0; k <= 16; ++k) { const float mag = expf((float)k * lr * dt); float sn, cs; sincosf((float)k * li * dt, &sn, &cs);
            PWr[(dir * 17 + k) * 64 + p] = mag * cs; PWi[(dir * 17 + k) * 64 + p] = mag * sn; }
        const float aa = lr * dt, th = li * dt; float sn, cs; sincosf(th, &sn, &cs); const float sh = sinf(0.5f * th);
        const float nr = expm1f(aa) * cs - 2.0f * sh * sh, ni = expf(aa) * sn;
        const float d2 = lr * lr + li * li; const float cr_ = (nr * lr + ni * li) / d2, ci_ = (ni * lr - nr * li) / d2;
        for (int h = 0; h < 16; ++h) { const float br = bre[(gi * 64 + p) * 16 + h], bi = bim[(gi * 64 + p) * 16 + h];
            BBr[(dir * 64 + p) * 16 + h] = cr_ * br - ci_ * bi; BBi[(dir * 64 + p) * 16 + h] = cr_ * bi + ci_ * br; }
    }
    for (int e = tid; e < 2048; e += 512) { const int dir = e >> 10, h = (e >> 6) & 15, p = e & 63; const int gi = dir * NG + g;
        Cr[e] = cre[(gi * 16 + h) * 64 + p]; Ci[e] = cim[(gi * 16 + h) * 64 + p]; }
    __syncthreads();
    {
        const int dir = tid >> 8, lag = (tid >> 4) & 15, h = tid & 15; float acc[16];
#pragma unroll
        for (int q = 0; q < 16; ++q) acc[q] = 0.f;
        for (int p = 0; p < 64; ++p) { const float c_r = Cr[(dir * 16 + h) * 64 + p], c_i = Ci[(dir * 16 + h) * 64 + p], w_r = PWr[(dir * 17 + lag) * 64 + p], w_i = PWi[(dir * 17 + lag) * 64 + p];
            const float zr = c_r * w_r - c_i * w_i, zi = c_r * w_i + c_i * w_r;
#pragma unroll
            for (int q = 0; q < 16; ++q) acc[q] += zr * BBr[(dir * 64 + p) * 16 + q] - zi * BBi[(dir * 64 + p) * 16 + q]; }
#pragma unroll
        for (int q = 0; q < 16; ++q) KT[((dir * 16 + lag) * 16 + h) * 16 + q] = acc[q];
    }
    __syncthreads();
    bf16* WY = (bf16*)(a.ws + WS_WY) + (size_t)g * 256 * 512; bf16* WSg = (bf16*)(a.ws + WS_WS) + (size_t)g * 256 * 256;
    for (int ch = tid; ch < 256 * 64; ch += 512) {
        const int m = ch >> 6, k0 = (ch & 63) * 8; const int t = m >> 4, h = m & 15; float v[8];
        if (k0 < 256) { const int j = k0 >> 4, hb = k0 & 15;
#pragma unroll
            for (int e = 0; e < 8; ++e) { const int hp = hb + e; float x;
                if (j < t) x = KT[((0 * 16 + (t - j)) * 16 + h) * 16 + hp]; else if (j > t) x = KT[((1 * 16 + (j - t)) * 16 + h) * 16 + hp];
                else { x = KT[((0 * 16 + 0) * 16 + h) * 16 + hp] + KT[((1 * 16 + 0) * 16 + h) * 16 + hp]; if (hp == h) x += dsk[g * 16 + h]; }
                v[e] = x; }
        } else { const int kk = k0 - 256; const int dir = kk >> 7, ri = (kk >> 6) & 1, pb = kk & 63; const int ex = dir == 0 ? t + 1 : 16 - t;
#pragma unroll
            for (int e = 0; e < 8; ++e) { const int p = pb + e; const float c_r = Cr[(dir * 16 + h) * 64 + p], c_i = Ci[(dir * 16 + h) * 64 + p], w_r = PWr[(dir * 17 + ex) * 64 + p], w_i = PWi[(dir * 17 + ex) * 64 + p];
                v[e] = ri == 0 ? (c_r * w_r - c_i * w_i) : -(c_r * w_i + c_i * w_r); }
        }
        v4u o; o.x = pk2(v[0], v[1]); o.y = pk2(v[2], v[3]); o.z = pk2(v[4], v[5]); o.w = pk2(v[6], v[7]);
        *(v4u*)(WY + (size_t)m * 512 + k0) = o;
    }
    for (int ch = tid; ch < 256 * 32; ch += 512) {
        const int m = ch >> 5, k0 = (ch & 31) * 8; const int dir = m >> 7, ri = (m >> 6) & 1, p = m & 63; const int j = k0 >> 4, hb = k0 & 15; const int ex = dir == 0 ? 15 - j : j;
        const float w_r = PWr[(dir * 17 + ex) * 64 + p], w_i = PWi[(dir * 17 + ex) * 64 + p]; float v[8];
#pragma unroll
        for (int e = 0; e < 8; ++e) { const float b_r = BBr[(dir * 64 + p) * 16 + hb + e], b_i = BBi[(dir * 64 + p) * 16 + hb + e]; v[e] = ri == 0 ? (w_r * b_r - w_i * b_i) : (w_r * b_i + w_i * b_r); }
        v4u o; o.x = pk2(v[0], v[1]); o.y = pk2(v[2], v[3]); o.z = pk2(v[4], v[5]); o.w = pk2(v[6], v[7]);
        *(v4u*)(WSg + (size_t)m * 256 + k0) = o;
    }
    __syncthreads();
}

template <int NT>
__device__ __forceinline__ void skinny16(const bf16* __restrict__ A, int K, const bf16* __restrict__ B0, const bf16* __restrict__ B1, f32x4& c0, f32x4& c1, int lane) {
    const int fr = lane & 15, fq = lane >> 4;
    const bf16* ap = A + (size_t)fr * K + 8 * fq; const bf16* bp0 = B0 + (size_t)fr * K + 8 * fq; const bf16* bp1 = B1 + (size_t)fr * K + 8 * fq;
    c0 = (f32x4){0.f, 0.f, 0.f, 0.f}; c1 = c0;
#pragma unroll 8
    for (int s = 0; s < K / 32; ++s) { const bf16x8 av = *(const bf16x8*)(ap + 32 * s); const bf16x8 b0 = *(const bf16x8*)(bp0 + 32 * s);
        c0 = MFMA16(av, b0, c0);
        if (NT == 2) { const bf16x8 b1 = *(const bf16x8*)(bp1 + 32 * s); c1 = MFMA16(av, b1, c1); } }
}

__device__ __forceinline__ bf16x8 pack8(f32x4 lo, f32x4 hi) { v4u w; w.x = pk2(lo.x, lo.y); w.y = pk2(lo.z, lo.w); w.z = pk2(hi.x, hi.y); w.w = pk2(hi.z, hi.w); return __builtin_bit_cast(bf16x8, w); }
__device__ __forceinline__ void na_job(int jid, int lane, const bf16* __restrict__ Q, const bf16* __restrict__ Kb, const bf16* __restrict__ Vt, const bf16* __restrict__ Km, const bf16* __restrict__ Vtm,
                                       const float* __restrict__ rpb, bf16* __restrict__ Ona) {
    const int j = jid & 3, r = (jid >> 2) & 31, h = (jid >> 7) & 7, b = jid >> 10;
    const int fr = lane & 15, fq = lane >> 4;
    const int rs = min(max(r - 4, 0), 24), c0 = min(max(16 * j - 8, 0), 32), cq = 16 * j + fr, cs = min(max(cq - 8, 0), 48);
    const size_t qtok = (size_t)b * SEQ + r * 64 + cq;
    const bf16x8 qf0 = *(const bf16x8*)(Q + qtok * 512 + h * 64 + 8 * fq), qf1 = *(const bf16x8*)(Q + qtok * 512 + h * 64 + 32 + 8 * fq);
    f32x4 sc[8][2], scm;
    const f32x4 z4 = (f32x4){0.f, 0.f, 0.f, 0.f};
#pragma unroll
    for (int kr = 0; kr < 8; ++kr)
#pragma unroll
        for (int t = 0; t < 2; ++t) { const int kc = c0 + 8 * (fr >> 2) + 4 * t + (fr & 3); const size_t tok = (size_t)b * SEQ + (rs + kr) * 64 + kc;
            const bf16x8 k0 = *(const bf16x8*)(Kb + tok * 512 + h * 64 + 8 * fq), k1 = *(const bf16x8*)(Kb + tok * 512 + h * 64 + 32 + 8 * fq);
            f32x4 acc = MFMA16(k0, qf0, z4); sc[kr][t] = MFMA16(k1, qf1, acc); }
    { const bf16x8 k0 = *(const bf16x8*)(Km + fr * 512 + h * 64 + 8 * fq), k1 = *(const bf16x8*)(Km + fr * 512 + h * 64 + 32 + 8 * fq);
      f32x4 acc = MFMA16(k0, qf0, z4); scm = MFMA16(k1, qf1, acc); }
    float mx = -3.0e38f;
    const float* rp = rpb + h * 15 * 31;
#pragma unroll
    for (int kr = 0; kr < 8; ++kr) { const int dr = rs + kr - r + 7;
#pragma unroll
        for (int t = 0; t < 2; ++t)
#pragma unroll
            for (int i = 0; i < 4; ++i) { const int kc = c0 + 8 * fq + 4 * t + i; const bool valid = (kc >= cs) && (kc < cs + 16); const int dc = min(max(kc - cq + 15, 0), 30);
                const float s = valid ? sc[kr][t][i] * 0.125f + rp[dr * 31 + dc] : -1.0e30f; sc[kr][t][i] = s; mx = fmaxf(mx, s); } }
#pragma unroll
    for (int i = 0; i < 4; ++i) { scm[i] *= 0.125f; mx = fmaxf(mx, scm[i]); }
    mx = fmaxf(mx, __shfl_xor(mx, 16)); mx = fmaxf(mx, __shfl_xor(mx, 32));
    float sum = 0.f;
#pragma unroll
    for (int kr = 0; kr < 8; ++kr)
#pragma unroll
        for (int t = 0; t < 2; ++t)
#pragma unroll
            for (int i = 0; i < 4; ++i) { const float p = __expf(sc[kr][t][i] - mx); sc[kr][t][i] = p; sum += p; }
#pragma unroll
    for (int i = 0; i < 4; ++i) { const float p = __expf(scm[i] - mx); scm[i] = p; sum += p; }
    sum += __shfl_xor(sum, 16); sum += __shfl_xor(sum, 32);
    const float inv = 1.0f / sum;
    f32x4 o[4] = {z4, z4, z4, z4};
#pragma unroll
    for (int kr = 0; kr < 8; ++kr) { const bf16x8 pb = pack8(sc[kr][0], sc[kr][1]);
        const size_t tok0 = (size_t)b * SEQ + (rs + kr) * 64 + c0 + 8 * fq;
#pragma unroll
        for (int dt = 0; dt < 4; ++dt) { const bf16x8 vf = *(const bf16x8*)(Vt + (size_t)(h * 64 + 16 * dt + fr) * MT + tok0); o[dt] = MFMA16(vf, pb, o[dt]); } }
    { const bf16x8 pb = pack8(scm, z4);
#pragma unroll
      for (int dt = 0; dt < 4; ++dt) { const v2u lo = *(const v2u*)(Vtm + (h * 64 + 16 * dt + fr) * 16 + 4 * fq); v4u w; w.x = lo.x; w.y = lo.y; w.z = 0u; w.w = 0u;
          o[dt] = MFMA16(__builtin_bit_cast(bf16x8, w), pb, o[dt]); } }
#pragma unroll
    for (int dt = 0; dt < 4; ++dt) { const f32x4 v = o[dt] * inv; v2u w; w.x = pk2(v.x, v.y); w.y = pk2(v.z, v.w);
        *(v2u*)(Ona + qtok * 1024 + h * 64 + 16 * dt + 4 * fq) = w; }
}

__device__ __forceinline__ void s5b_job(int jid, int lane, const bf16* __restrict__ U, const bf16* __restrict__ Um, const bf16* __restrict__ WS, float* __restrict__ S) {
    const bool meta = jid >= 2048; const int g = meta ? jid - 2048 : (jid >> 6), nt = jid & 63;
    const int fr = lane & 15, fq = lane >> 4; const int cc = nt * 16 + fr;
    const bf16* ub = meta ? Um + (fq >> 1) * 512 + 16 * g + 8 * (fq & 1) : U + ((size_t)cc * 16 + (fq >> 1)) * 512 + 16 * g + 8 * (fq & 1);
    bf16x8 uf[8];
#pragma unroll
    for (int s = 0; s < 8; ++s) uf[s] = *(const bf16x8*)(ub + (2 * s) * 512);
    const bf16* wp = WS + (size_t)g * 65536 + fr * 256 + 8 * fq;
    const int b = cc >> 7, c = (cc & 127) + 1;
    float* sp = meta ? S + ((size_t)(fr * NCH) * NG + g) * 256 + 4 * fq : S + ((size_t)(b * NCH + c) * NG + g) * 256 + 4 * fq;
    const bool wr = !meta || fr < NB;
#pragma unroll 2
    for (int mt = 0; mt < 16; ++mt) { f32x4 acc = (f32x4){0.f, 0.f, 0.f, 0.f};
#pragma unroll
        for (int s = 0; s < 8; ++s) { const bf16x8 af = *(const bf16x8*)(wp + mt * 4096 + 32 * s); acc = MFMA16(af, uf[s], acc); }
        if (wr) *(f32x4*)(sp + 16 * mt) = acc; }
}
__device__ __forceinline__ void s5c_job(int wid, int lane, const Args& a, const float* __restrict__ S, bf16* __restrict__ XX) {
    const int dir = wid & 1, g = (wid >> 1) & 31, b = wid >> 6, p = lane; const int gi = dir * NG + g;
    const float dt = expf(a.in[I_LOGDT][gi]); const float lr = a.in[I_LRE][gi * 64 + p], li = a.in[I_LIM][gi * 64 + p];
    const float mag = expf(16.0f * lr * dt); float sn, cs; sincosf(16.0f * li * dt, &sn, &cs); const float ar = mag * cs, ai = mag * sn;
    float xr = 0.f, xi = 0.f;
#pragma unroll 8
    for (int st = 0; st < NCH; ++st) { const int c = dir == 0 ? st : NCH - 1 - st; const size_t idx = ((size_t)(b * NCH + c) * NG + g) * 256 + dir * 128 + p;
        XX[idx] = (bf16)f2bf(xr); XX[idx + 64] = (bf16)f2bf(xi);
        const float sr = S[idx], si = S[idx + 64]; const float nr = ar * xr - ai * xi + sr, ni = ar * xi + ai * xr + si; xr = nr; xi = ni; }
}
__device__ __forceinline__ float gelu_tanh(float x) { const float z = 0.7978845608028654f * (x + 0.044715f * x * x * x); const float e = __expf(2.0f * z); const float th = 1.0f - 2.0f / (e + 1.0f); return 0.5f * x * (1.0f + th); }
__device__ __forceinline__ void s5d_job(int jid, int lane, const bf16* __restrict__ U, const bf16* __restrict__ XX, const bf16* __restrict__ WY, bf16* __restrict__ Yg) {
    const int g = jid >> 6, nt = jid & 63; const int fr = lane & 15, fq = lane >> 4; const int cc = nt * 16 + fr; const int b = cc >> 7, c = (cc & 127) + 1;
    const bf16* ub = U + ((size_t)cc * 16 + (fq >> 1)) * 512 + 16 * g + 8 * (fq & 1);
    const bf16* xp = XX + ((size_t)(b * NCH + c) * NG + g) * 256 + 8 * fq;
    bf16x8 uf[8], xf[8];
#pragma unroll
    for (int s = 0; s < 8; ++s) { uf[s] = *(const bf16x8*)(ub + (2 * s) * 512); xf[s] = *(const bf16x8*)(xp + 32 * s); }
    const bf16* wp = WY + (size_t)g * 131072 + fr * 512 + 8 * fq;
#pragma unroll 2
    for (int mt = 0; mt < 16; ++mt) { f32x4 acc = (f32x4){0.f, 0.f, 0.f, 0.f};
#pragma unroll
        for (int s = 0; s < 8; ++s) { const bf16x8 af = *(const bf16x8*)(wp + mt * 8192 + 32 * s); acc = MFMA16(af, uf[s], acc); }
#pragma unroll
        for (int s = 0; s < 8; ++s) { const bf16x8 af = *(const bf16x8*)(wp + mt * 8192 + 256 + 32 * s); acc = MFMA16(af, xf[s], acc); }
        v2u w; w.x = pk2(gelu_tanh(acc.x), gelu_tanh(acc.y)); w.y = pk2(gelu_tanh(acc.z), gelu_tanh(acc.w));
        *(v2u*)(Yg + ((size_t)cc * 16 + mt) * 512 + 16 * g + 4 * fq) = w; }
}
__device__ __forceinline__ void mix_row(bf16* row, const float* __restrict__ gna, const float* __restrict__ gs5, int lane) {
    v4u x0 = ((const v4u*)row)[lane], x1 = ((const v4u*)row)[64 + lane];
    float a[8], c[8];
    a[0] = bflo(x0.x); a[1] = bfhi(x0.x); a[2] = bflo(x0.y); a[3] = bfhi(x0.y); a[4] = bflo(x0.z); a[5] = bfhi(x0.z); a[6] = bflo(x0.w); a[7] = bfhi(x0.w);
    c[0] = bflo(x1.x); c[1] = bfhi(x1.x); c[2] = bflo(x1.y); c[3] = bfhi(x1.y); c[4] = bflo(x1.z); c[5] = bfhi(x1.z); c[6] = bflo(x1.w); c[7] = bfhi(x1.w);
    float s0 = 0.f, s1 = 0.f;
#pragma unroll
    for (int e = 0; e < 8; ++e) { s0 += a[e] * a[e]; s1 += c[e] * c[e]; }
    const float r0 = 1.0f / sqrtf(wave_sum(s0) * (1.0f / 512.0f) + RMS_EPS), r1 = 1.0f / sqrtf(wave_sum(s1) * (1.0f / 512.0f) + RMS_EPS);
    const f32x4 g00 = ((const f32x4*)gna)[2 * lane], g01 = ((const f32x4*)gna)[2 * lane + 1], g10 = ((const f32x4*)gs5)[2 * lane], g11 = ((const f32x4*)gs5)[2 * lane + 1];
    v4u o0, o1;
    o0.x = pk2(a[0] * r0 * g00.x, a[1] * r0 * g00.y); o0.y = pk2(a[2] * r0 * g00.z, a[3] * r0 * g00.w); o0.z = pk2(a[4] * r0 * g01.x, a[5] * r0 * g01.y); o0.w = pk2(a[6] * r0 * g01.z, a[7] * r0 * g01.w);
    o1.x = pk2(c[0] * r1 * g10.x, c[1] * r1 * g10.y); o1.y = pk2(c[2] * r1 * g10.z, c[3] * r1 * g10.w); o1.z = pk2(c[4] * r1 * g11.x, c[5] * r1 * g11.y); o1.w = pk2(c[6] * r1 * g11.z, c[7] * r1 * g11.w);
    ((v4u*)row)[lane] = o0; ((v4u*)row)[64 + lane] = o1;
}
__global__ void __launch_bounds__(NWAVES * 64, 2) hyb_fwd(Args args) {
    extern __shared__ __attribute__((aligned(16))) unsigned char lds_raw[];
    cg::grid_group grid = cg::this_grid();
    LAS unsigned char* lds = (LAS unsigned char*)lds_raw;
    const int tid = threadIdx.x, lane = tid & 63, wave = __builtin_amdgcn_readfirstlane(tid >> 6);
    const int G = gridDim.x, bx = blockIdx.x;
    const int gw = bx * NWAVES + wave, NGW = G * NWAVES;
    const int sw = wave * G + bx;
    unsigned char* ws = args.ws;
    bf16* A1M = (bf16*)(ws + WS_META + OM_A1); bf16* ACTM = (bf16*)(ws + WS_META + OM_ACT); float* FM = (float*)(ws + WS_META + OM_F); bf16* A2M = (bf16*)(ws + WS_META + OM_A2);
    bf16* KM = (bf16*)(ws + WS_META + OM_K); bf16* UM = (bf16*)(ws + WS_META + OM_U); bf16* VTM = (bf16*)(ws + WS_META + OM_VT);
    bf16* WGU1 = (bf16*)(ws + WS_WGU1); bf16* WD1 = (bf16*)(ws + WS_WD1); bf16* WQKU = (bf16*)(ws + WS_WQKU); bf16* WV = (bf16*)(ws + WS_WV); bf16* WGLU = (bf16*)(ws + WS_WGLU);
    bf16* WOUT = (bf16*)(ws + WS_WOUT); bf16* WGU2 = (bf16*)(ws + WS_WGU2); bf16* WD2 = (bf16*)(ws + WS_WD2); bf16* WSS = (bf16*)(ws + WS_WS); bf16* WY = (bf16*)(ws + WS_WY);
    bf16* AB = (bf16*)(ws + WS_A); float* HB = (float*)(ws + WS_H); bf16* ACT = (bf16*)(ws + WS_ACT);
    bf16* QB = (bf16*)(ws + WS_Q); bf16* KB = (bf16*)(ws + WS_K); bf16* VT = (bf16*)(ws + WS_VT); bf16* UB = (bf16*)(ws + WS_U); bf16* YG = (bf16*)(ws + WS_YG);
    float* FO = args.out;
    float* SS = (float*)((unsigned char*)args.out + OUT_S); bf16* XX = (bf16*)((unsigned char*)args.out + OUT_XX);
    const float* X = args.in[I_X];
#define GSYNC() grid.sync()

    if (bx < NG) s5_prep_group(args, bx, (LAS float*)lds, tid);
    {
        LAS float* scr = (LAS float*)(lds + wave * 16384);
        constexpr int IT_FF = 1408, IT_IN = 1024, IT_GLU = 128, IT_OUT = 512;
        constexpr int NITEMS = 6 * IT_FF + IT_IN + IT_GLU + IT_OUT;
        for (int it = gw; it < NITEMS; it += NGW) {
            int r = it;
            if (r < 2 * IT_FF) { const bool up = r >= IT_FF; if (up) r -= IT_FF; const int kb = r / 88, nb = r % 88, n0 = nb * 32;
                tr_item(args.in[up ? I_F1WU : I_F1WG], 1024, DFF, kb * 64, n0, WGU1 + (size_t)(256 * (n0 >> 7) + (n0 & 127) + (up ? 128 : 0)) * 1024, scr, lane); continue; } r -= 2 * IT_FF;
            if (r < IT_FF) { const int kb = r / 32, nb = r % 32; tr_item(args.in[I_F1WD], DFF, 1024, kb * 64, nb * 32, WD1 + (size_t)(nb * 32) * DFF, scr, lane); continue; } r -= IT_FF;
            if (r < IT_IN) { const int kb = r / 64, nb = r % 64, n0 = nb * 32;
                bf16* dst = n0 < 1024 ? WQKU + (size_t)n0 * 1024 : (n0 < 1536 ? WV + (size_t)(n0 - 1024) * 1024 : WQKU + (size_t)(n0 - 512) * 1024);
                tr_item(args.in[I_WIN], 1024, 2048, kb * 64, n0, dst, scr, lane); continue; } r -= IT_IN;
            if (r < IT_GLU) { const int kb = r / 16, nb = r % 16; tr_item(args.in[I_WGLU], 512, 512, kb * 64, nb * 32, WGLU + (size_t)(nb * 32) * 512, scr, lane); continue; } r -= IT_GLU;
            if (r < IT_OUT) { const int kb = r / 32, nb = r % 32; tr_item(args.in[I_WOUT], 1024, 1024, kb * 64, nb * 32, WOUT + (size_t)(nb * 32) * 1024, scr, lane); continue; } r -= IT_OUT;
            if (r < 2 * IT_FF) { const bool up = r >= IT_FF; if (up) r -= IT_FF; const int kb = r / 88, nb = r % 88, n0 = nb * 32;
                tr_item(args.in[up ? I_F2WU : I_F2WG], 1024, DFF, kb * 64, n0, WGU2 + (size_t)(256 * (n0 >> 7) + (n0 & 127) + (up ? 128 : 0)) * 1024, scr, lane); continue; } r -= 2 * IT_FF;
            { const int kb = r / 32, nb = r % 32; tr_item(args.in[I_F2WD], DFF, 1024, kb * 64, nb * 32, WD2 + (size_t)(nb * 32) * DFF, scr, lane); }
        }
        for (int m = gw; m < MT + 16; m += NGW) {
            if (m < MT) row_norm_bf16(X + (size_t)m * DM, args.in[I_F1PRE], AB + (size_t)m * DM, lane);
            else row_norm_bf16(args.in[I_META] + (size_t)(m - MT) * DM, args.in[I_F1PRE], A1M + (size_t)(m - MT) * DM, lane);
        }
    }
    GSYNC();

    if (sw < 176) { const int pn = sw >> 3, qq = sw & 7; f32x4 c0, c1;
        skinny16<2>(A1M, 1024, WGU1 + (size_t)(256 * pn + 16 * qq) * 1024, WGU1 + (size_t)(256 * pn + 128 + 16 * qq) * 1024, c0, c1, lane);
        const int fr = lane & 15, fq = lane >> 4;
#pragma unroll
        for (int i = 0; i < 4; ++i) ACTM[(4 * fq + i) * DFF + 128 * pn + 16 * qq + fr] = (bf16)f2bf(c0[i] * pg8::fast_sigmoid(c0[i]) * c1[i]); }
    { pg8::Gemm g{AB, WGU1, MT, 2 * DFF, 1024}; pg8::StaticOrder S; S.init(MT, 2 * DFF, G, bx); pg8::EpiSwiGLU E{ACT, DFF};
      pg8::gemm_phase<pg8::EpiSwiGLU, pg8::StaticOrder, true, true>(lds, g, S, E); }
    GSYNC();

    if (sw < 64) { f32x4 c0, c1; skinny16<1>(ACTM, DFF, WD1 + (size_t)(16 * sw) * DFF, WD1, c0, c1, lane); const int fr = lane & 15, fq = lane >> 4;
#pragma unroll
        for (int i = 0; i < 4; ++i) FM[(4 * fq + i) * 1024 + 16 * sw + fr] = c0[i]; }
    { pg8::Gemm g{ACT, WD1, MT, 1024, DFF}; pg8::StaticOrder S; S.init(MT, 1024, G, bx); pg8::EpiF32 E{FO, 1024};
      pg8::gemm_phase<pg8::EpiF32, pg8::StaticOrder, true, true>(lds, g, S, E); }
    GSYNC();

    for (int m = gw; m < MT + 16; m += NGW) {
        if (m < MT) row_res_norm(X + (size_t)m * DM, FO + (size_t)m * DM, args.in[I_F1POST], 0.5f, HB + (size_t)m * DM, args.in[I_MIXPRE], AB + (size_t)m * DM, nullptr, lane);
        else { const int q = m - MT; row_res_norm(args.in[I_META] + (size_t)q * DM, FM + (size_t)q * DM, args.in[I_F1POST], 0.5f, nullptr, args.in[I_MIXPRE], A2M + (size_t)q * DM, nullptr, lane); }
    }
    GSYNC();

    if (sw < 96) { f32x4 c0, c1; const int fr = lane & 15, fq = lane >> 4;
        if (sw < 64) { skinny16<1>(A2M, 1024, WQKU + (size_t)(512 + 16 * sw) * 1024, WQKU, c0, c1, lane);
            bf16* dst = sw < 32 ? KM + 16 * sw : UM + 16 * (sw - 32);
#pragma unroll
            for (int i = 0; i < 4; ++i) dst[(4 * fq + i) * 512 + fr] = (bf16)f2bf(c0[i]); }
        else { const int q = sw - 64; skinny16<1>(A2M, 1024, WV + (size_t)(16 * q) * 1024, WV, c0, c1, lane);
            v2u w; w.x = pk2(c0[0], c0[1]); w.y = pk2(c0[2], c0[3]); *(v2u*)(VTM + (16 * q + fr) * 16 + 4 * fq) = w; } }
    { pg8::Gemm g{AB, WQKU, MT, 1536, 1024}; pg8::StaticOrder S; S.init(MT, 1536, G, bx); pg8::EpiBf16<0> E{QB, 512, nullptr, 512, (size_t)MT * 512, 1.f};
      pg8::gemm_phase<pg8::EpiBf16<0>, pg8::StaticOrder, true, true>(lds, g, S, E); }
    { const bool trick = (G == 256);
      if (!trick || bx >= 128) { pg8::Gemm g{WV, AB, 512, MT, 1024}; pg8::StaticOrder S; S.init(512, MT, G, trick ? bx - 128 : bx); pg8::EpiBf16<0> E{VT, MT, nullptr, 0, 0, 1.f};
          pg8::gemm_phase<pg8::EpiBf16<0>, pg8::StaticOrder, true, true>(lds, g, S, E); } }
    GSYNC();

    for (int j = gw; j < 2080; j += NGW) s5b_job(j, lane, UB, UM, WSS, SS);
    for (int j = gw; j < 8192; j += NGW) na_job(j, lane, QB, KB, VT, KM, VTM, args.in[I_RPB], AB);
    GSYNC();

    for (int j = sw; j < 512; j += NGW) s5c_job(j, lane, args, SS, XX);
    GSYNC();

    for (int j = gw; j < 2048; j += NGW) s5d_job(j, lane, UB, XX, WY, YG);
    GSYNC();

    { pg8::Gemm g{YG, WGLU, MT, 512, 512}; pg8::StaticOrder S; S.init(MT, 512, G, bx); pg8::EpiGLU E{YG, 512, args.in[I_BGLU], AB + 512, 1024};
      pg8::gemm_phase<pg8::EpiGLU, pg8::StaticOrder, true, true>(lds, g, S, E); }
    GSYNC();

    for (int m = gw; m < MT; m += NGW) mix_row(AB + (size_t)m * DM, args.in[I_NAG], args.in[I_S5G], lane);
    GSYNC();

    { pg8::Gemm g{AB, WOUT, MT, 1024, 1024}; pg8::StaticOrder S; S.init(MT, 1024, G, bx); pg8::EpiF32 E{FO, 1024};
      pg8::gemm_phase<pg8::EpiF32, pg8::StaticOrder, true, true>(lds, g, S, E); }
    GSYNC();

    for (int m = gw; m < MT; m += NGW) row_res_norm(HB + (size_t)m * DM, FO + (size_t)m * DM, args.in[I_MIXPOST], 1.0f, HB + (size_t)m * DM, args.in[I_F2PRE], AB + (size_t)m * DM, nullptr, lane);
    GSYNC();

    { pg8::Gemm g{AB, WGU2, MT, 2 * DFF, 1024}; pg8::StaticOrder S; S.init(MT, 2 * DFF, G, bx); pg8::EpiSwiGLU E{ACT, DFF};
      pg8::gemm_phase<pg8::EpiSwiGLU, pg8::StaticOrder, true, true>(lds, g, S, E); }
    GSYNC();

    { pg8::Gemm g{ACT, WD2, MT, 1024, DFF}; pg8::StaticOrder S; S.init(MT, 1024, G, bx); pg8::EpiF32 E{FO, 1024};
      pg8::gemm_phase<pg8::EpiF32, pg8::StaticOrder, true, true>(lds, g, S, E); }
    GSYNC();

    for (int m = gw; m < MT; m += NGW) row_res_norm(HB + (size_t)m * DM, FO + (size_t)m * DM, args.in[I_F2POST], 0.5f, nullptr, args.in[I_FINAL], nullptr, FO + (size_t)m * DM, lane);
}

extern "C" void kernel_launch(void* const* d_in, const int* in_sizes, int n_in, void* d_out, int out_size, void* d_ws, size_t ws_size, hipStream_t stream) {
    static int grid_blocks = 0;
    if (grid_blocks == 0) {
        if (n_in != N_IN || out_size != MT * DM || ws_size < WS_END) { fprintf(stderr, "kernel_launch: unexpected problem (n_in %d out %d ws %zu)\n", n_in, out_size, ws_size); grid_blocks = -1; return; }
        int dev = 0, cus = 0, per_cu = 0;
        (void)hipGetDevice(&dev); (void)hipDeviceGetAttribute(&cus, hipDeviceAttributeMultiprocessorCount, dev);
        (void)hipFuncSetAttribute((const void*)hyb_fwd, hipFuncAttributeMaxDynamicSharedMemorySize, LDS_BYTES);
        (void)hipOccupancyMaxActiveBlocksPerMultiprocessor(&per_cu, (const void*)hyb_fwd, NWAVES * 64, LDS_BYTES);
        if (per_cu < 1) { fprintf(stderr, "kernel_launch: occupancy query reports %d blocks per CU\n", per_cu); per_cu = 1; }
        (void)hipGetLastError();
        grid_blocks = cus;
    }
    if (grid_blocks < 0) return;
    Args a{};
    for (int i = 0; i < N_IN; ++i) a.in[i] = (const float*)d_in[i];
    a.out = (float*)d_out; a.ws = (unsigned char*)d_ws;
    void* kargs[] = {&a};
    hipError_t e = hipLaunchCooperativeKernel((const void*)hyb_fwd, dim3(grid_blocks), dim3(NWAVES * 64), kargs, LDS_BYTES, stream);
    if (e != hipSuccess) fprintf(stderr, "cooperative launch failed: %s (grid %d)\n", hipGetErrorString(e), grid_blocks);
}
```

```cpp
#include <hip/hip_runtime.h>
#include <hip/hip_cooperative_groups.h>
#include <cstdio>
#include <cstdint>
namespace cg = cooperative_groups;
#define PROBE_NA 0
#define PROBE_S5B 0
#define PROBE_S5C 0
#define PROBE_S5D 0
#define PROBE_SYNC 0
namespace pg8 {
#define PG8_LAS __attribute__((address_space(3)))
typedef unsigned short bf16_t;
typedef short bf16x8 __attribute__((ext_vector_type(8)));
typedef float f32x4 __attribute__((ext_vector_type(4)));
typedef unsigned u32x4 __attribute__((ext_vector_type(4)));
constexpr int BM = 256, BK = 64, HALF = 128, HTB = HALF * BK * 2  , STAGE_BYTES = 8 * HTB, NXCD = 8, WGM = 8;

__host__ __device__ __forceinline__ int lds_byte(int r, int c) { const int st = (r >> 4) * 2 + (c >> 5), rr = r & 15, cc = c & 31, ob = rr * 64 + cc * 2; return st * 1024 + (ob ^ (((ob >> 9) & 1) << 5)); }
__host__ __device__ __forceinline__ void stage_rc(int b, int& R, int& C) { const int st = b / 1024, sb = b % 1024, swz = sb ^ (((sb >> 9) & 1) << 5); R = (st >> 1) * 16 + swz / 64; C = (st & 1) * 32 + (swz % 64) / 2; }
__host__ __device__ __forceinline__ int perm32(int rho) { const int n = rho >> 4, i = rho & 15; return 8 * (i >> 2) + 4 * n + (i & 3); }

struct Unit { int pm, pn; };
struct Gemm { const bf16_t* A; const bf16_t* Bt; int M, N, K; };

struct StaticOrder {
    int nM, nN, nwg, G, c;
    __host__ __device__ void init(int M, int N, int G_, int c_) { nM = M / BM; nN = N / BM; nwg = nM * nN; G = G_; c = c_; }
    __host__ __device__ bool next(int i, Unit& u) const {
        const long L = (long)i * G + c; if (L >= nwg) return false;
        int wgid = (int)L; { const int q = nwg / NXCD, r = nwg % NXCD, xcd = wgid % NXCD, off = wgid / NXCD; wgid = (xcd < r ? xcd * (q + 1) : r * (q + 1) + (xcd - r) * q) + off; }
        const int nig = WGM * nN, gid = wgid / nig, fm = gid * WGM, gsz = (nM - fm) < WGM ? (nM - fm) : WGM;
        u.pm = fm + ((wgid % nig) % gsz); u.pn = (wgid % nig) / gsz; return true;
    }
    __device__ __forceinline__ void a_ready(const Unit&) const {}
    __device__ __forceinline__ void done(const Unit&) const {}
};

__device__ __forceinline__ unsigned cvt_pk_bf16(float lo, float hi) { unsigned r; asm volatile("v_cvt_pk_bf16_f32 %0, %1, %2" : "=v"(r) : "v"(lo), "v"(hi)); return r; }
typedef float f32x2 __attribute__((ext_vector_type(2)));
__device__ __forceinline__ f32x2 gelu_pk(f32x2 v) {
    const f32x2 av = __builtin_elementwise_abs(v), d = av * 0.2316418882f + 1.0f;
    f32x2 t; t.x = __builtin_amdgcn_rcpf(d.x); t.y = __builtin_amdgcn_rcpf(d.y);
    f32x2 q = t * 0.5307027145f + (-0.7265760135f); q = q * t + 0.7107068705f; q = q * t + (-0.142248368f); q = q * t + 0.127414796f; q = q * t;
    const f32x2 s = (v * v) * (-0.72134752044f);
    f32x2 e; e.x = __builtin_amdgcn_exp2f(s.x); e.y = __builtin_amdgcn_exp2f(s.y);
    const f32x2 m = v * (q * e), r = v - m;
    f32x2 o; o.x = v.x < 0.f ? m.x : r.x; o.y = v.y < 0.f ? m.y : r.y; return o;
}

template <int ACT  > struct EpiBf16 {
    static constexpr bool PERM = true, AFTER_DRAIN = false; static_assert(ACT == 0 || ACT == 1, "EpiBf16: ACT is 0 (none) or 1 (gelu_pk)");
    bf16_t* O; int ldc; const float* bias; int split_cols; size_t split_stride; float scale0;
    __device__ __forceinline__ void operator()(const f32x4 (&acc)[2][2][4][2], const Unit& u, int wr, int wc, int fr, int fq) const {
        const int row0 = u.pm * BM + wr * 64 + fr; int colt = u.pn * BM; bf16_t* base = O;
        float sc = 1.f; if (split_cols) { const int t = colt / split_cols; base += (size_t)t * split_stride; colt -= t * split_cols; if (t == 0) sc = scale0; }
        const int col0 = colt + wc * 32 + 8 * fq, bcol0 = u.pn * BM + wc * 32 + 8 * fq;
        f32x4 bv[2][2];
#pragma unroll
        for (int bj = 0; bj < 2; ++bj)
#pragma unroll
            for (int n = 0; n < 2; ++n) bv[bj][n] = bias ? *(const f32x4*)(bias + bcol0 + bj * HALF + 4 * n) : (f32x4){0.f, 0.f, 0.f, 0.f};
#pragma unroll
        for (int ai = 0; ai < 2; ++ai)
#pragma unroll
            for (int m = 0; m < 4; ++m) { bf16_t* rowp = base + (size_t)(row0 + ai * HALF + m * 16) * ldc + col0;
#pragma unroll
                for (int bj = 0; bj < 2; ++bj) { f32x4 v0 = acc[ai][bj][m][0] + bv[bj][0], v1 = acc[ai][bj][m][1] + bv[bj][1];
                    if (ACT == 1) { f32x2 a = gelu_pk((f32x2){v0[0], v0[1]}), b = gelu_pk((f32x2){v0[2], v0[3]}), c = gelu_pk((f32x2){v1[0], v1[1]}), d = gelu_pk((f32x2){v1[2], v1[3]});
                        v0 = (f32x4){a.x, a.y, b.x, b.y}; v1 = (f32x4){c.x, c.y, d.x, d.y}; }
                    v0 = v0 * sc; v1 = v1 * sc; u32x4 w; w.x = cvt_pk_bf16(v0[0], v0[1]); w.y = cvt_pk_bf16(v0[2], v0[3]); w.z = cvt_pk_bf16(v1[0], v1[1]); w.w = cvt_pk_bf16(v1[2], v1[3]);
                    *(u32x4*)(rowp + bj * HALF) = w; } }
    }
};
__device__ __forceinline__ float fast_sigmoid(float x) { return __builtin_amdgcn_rcpf(1.0f + __builtin_amdgcn_exp2f(-1.44269504089f * x)); }
struct EpiSwiGLU {
    static constexpr bool PERM = true, AFTER_DRAIN = false;
    bf16_t* O; int ldc;
    __device__ __forceinline__ void operator()(const f32x4 (&acc)[2][2][4][2], const Unit& u, int wr, int wc, int fr, int fq) const {
        const int row0 = u.pm * BM + wr * 64 + fr; const int col0 = u.pn * HALF + wc * 32 + 8 * fq;
#pragma unroll
        for (int ai = 0; ai < 2; ++ai)
#pragma unroll
            for (int m = 0; m < 4; ++m) { bf16_t* rowp = O + (size_t)(row0 + ai * HALF + m * 16) * ldc + col0;
                f32x4 g0 = acc[ai][0][m][0], g1 = acc[ai][0][m][1], u0 = acc[ai][1][m][0], u1 = acc[ai][1][m][1];
                f32x4 v0, v1;
#pragma unroll
                for (int e = 0; e < 4; ++e) { v0[e] = g0[e] * fast_sigmoid(g0[e]) * u0[e]; v1[e] = g1[e] * fast_sigmoid(g1[e]) * u1[e]; }
                u32x4 w; w.x = cvt_pk_bf16(v0[0], v0[1]); w.y = cvt_pk_bf16(v0[2], v0[3]); w.z = cvt_pk_bf16(v1[0], v1[1]); w.w = cvt_pk_bf16(v1[2], v1[3]);
                *(u32x4*)rowp = w; }
    }
};
struct EpiF32 {
    static constexpr bool PERM = false, AFTER_DRAIN = false;
    float* O; int ldc;
    __device__ __forceinline__ void operator()(const f32x4 (&acc)[2][2][4][2], const Unit& u, int wr, int wc, int fr, int fq) const {
        const int row0 = u.pm * BM + wr * 64 + fr; const int col0 = u.pn * BM + wc * 32 + 4 * fq;
#pragma unroll
        for (int ai = 0; ai < 2; ++ai)
#pragma unroll
            for (int m = 0; m < 4; ++m) { float* rowp = O + (size_t)(row0 + ai * HALF + m * 16) * ldc + col0;
#pragma unroll
                for (int bj = 0; bj < 2; ++bj)
#pragma unroll
                    for (int n = 0; n < 2; ++n) *(f32x4*)(rowp + bj * HALF + n * 16) = acc[ai][bj][m][n]; }
    }
};
struct EpiGLU {
    static constexpr bool PERM = true, AFTER_DRAIN = false;
    const bf16_t* Y; int ldy; const float* bias; bf16_t* O; int ldc;
    __device__ __forceinline__ void operator()(const f32x4 (&acc)[2][2][4][2], const Unit& u, int wr, int wc, int fr, int fq) const {
        const int row0 = u.pm * BM + wr * 64 + fr; const int col0 = u.pn * BM + wc * 32 + 8 * fq;
#pragma unroll
        for (int ai = 0; ai < 2; ++ai)
#pragma unroll
            for (int m = 0; m < 4; ++m) { const size_t row = (size_t)(row0 + ai * HALF + m * 16);
#pragma unroll
                for (int bj = 0; bj < 2; ++bj) { const int c = col0 + bj * HALF;
                    const u32x4 yv = *(const u32x4*)(Y + row * ldy + c);
                    const f32x4 b0 = *(const f32x4*)(bias + c), b1 = *(const f32x4*)(bias + c + 4);
                    const f32x4 z0 = acc[ai][bj][m][0] + b0, z1 = acc[ai][bj][m][1] + b1;
                    float y[8]; y[0] = __uint_as_float(yv.x << 16); y[1] = __uint_as_float(yv.x & 0xffff0000u); y[2] = __uint_as_float(yv.y << 16); y[3] = __uint_as_float(yv.y & 0xffff0000u);
                    y[4] = __uint_as_float(yv.z << 16); y[5] = __uint_as_float(yv.z & 0xffff0000u); y[6] = __uint_as_float(yv.w << 16); y[7] = __uint_as_float(yv.w & 0xffff0000u);
                    u32x4 w; w.x = cvt_pk_bf16(y[0] * fast_sigmoid(z0[0]), y[1] * fast_sigmoid(z0[1])); w.y = cvt_pk_bf16(y[2] * fast_sigmoid(z0[2]), y[3] * fast_sigmoid(z0[3]));
                    w.z = cvt_pk_bf16(y[4] * fast_sigmoid(z1[0]), y[5] * fast_sigmoid(z1[1])); w.w = cvt_pk_bf16(y[6] * fast_sigmoid(z1[2]), y[7] * fast_sigmoid(z1[3]));
                    *(u32x4*)(O + row * ldc + c) = w; } }
    }
};
template <class Epi, class Sched, bool ALIGN_EPI = false, bool SP2 = false>
__device__ __forceinline__ void gemm_phase(PG8_LAS unsigned char* lds, const Gemm g, const Sched& S, const Epi& E) {
    const int tid = threadIdx.x, wid = __builtin_amdgcn_readfirstlane(tid >> 6), lane = tid & 63, wr = wid >> 2, wc = wid & 3, fr = lane & 15, fq = lane >> 4;
    const int K = g.K, nt = K / BK;
    unsigned voffA[2], voffB[2];
#pragma unroll
    for (int i = 0; i < 2; ++i) { int R, C; stage_rc(tid * 16 + i * 8192, R, C); const int Rb = Epi::PERM ? ((R & ~31) + perm32(R & 31)) : R;
        voffA[i] = (unsigned)(R * K + C) * 2u; voffB[i] = (unsigned)(Rb * K + C) * 2u; }
    const size_t kstep = (size_t)(BK * 2);
    const size_t hstep = (size_t)HALF * K * 2;
    const size_t tstep = 2 * hstep;
    const unsigned ldsw = (unsigned)wid * 1024u;
    const int aoff = lds_byte(wr * 64 + fr, fq * 8), boff = lds_byte(wc * 32 + fr, fq * 8);
#define PG8_SA(b, h) (((b) * 2 + (h)) * HTB)
#define PG8_SB(b, h) ((4 + (b) * 2 + (h)) * HTB)
#define PG8_STAGE(bufoff, gbase, voff) do { _Pragma("unroll") for (int _i = 0; _i < 2; ++_i) \
        __builtin_amdgcn_global_load_lds((const unsigned*)((const char*)(gbase) + (voff)[_i]), (PG8_LAS unsigned*)(lds + (bufoff) + ldsw + _i * 8192), 16, 0, 0); } while (0)
#define PG8_LDA(dst, b, h) do { _Pragma("unroll") for (int m = 0; m < 4; ++m) _Pragma("unroll") for (int k = 0; k < 2; ++k) dst[m][k] = *(const PG8_LAS bf16x8*)(lds + PG8_SA(b, h) + aoff + m * 2048 + k * 1024); } while (0)
#define PG8_LDB(dst, b, h) do { _Pragma("unroll") for (int n = 0; n < 2; ++n) _Pragma("unroll") for (int k = 0; k < 2; ++k) dst[n][k] = *(const PG8_LAS bf16x8*)(lds + PG8_SB(b, h) + boff + n * 2048 + k * 1024); } while (0)
#define PG8_MMA(ai, bj, At, Bt) do { __builtin_amdgcn_s_setprio(1); _Pragma("unroll") for (int m = 0; m < 4; ++m) _Pragma("unroll") for (int n = 0; n < 2; ++n) _Pragma("unroll") for (int k = 0; k < 2; ++k) \
        acc[ai][bj][m][n] = __builtin_amdgcn_mfma_f32_16x16x32_bf16(Bt[n][k], At[m][k], acc[ai][bj][m][n], 0, 0, 0); __builtin_amdgcn_s_setprio(0); } while (0)
#define PG8_WAIT_V(n) asm volatile("s_waitcnt vmcnt(" #n ")" ::: "memory")
#define PG8_WAIT_L(n) asm volatile("s_waitcnt lgkmcnt(" #n ")" ::: "memory")
#define PG8_BAR __builtin_amdgcn_s_barrier()
#define PG8_SCHED __builtin_amdgcn_sched_barrier(0)
    Unit cur, nxt; int ui = 0;
    if (!S.next(0, cur)) return;
    f32x4 acc[2][2][4][2];
#pragma unroll
    for (int a = 0; a < 2; ++a)
#pragma unroll
        for (int b = 0; b < 2; ++b)
#pragma unroll
            for (int m = 0; m < 4; ++m)
#pragma unroll
                for (int n = 0; n < 2; ++n) acc[a][b][m][n] = (f32x4){0.f, 0.f, 0.f, 0.f};
    bf16x8 At[4][2], B0[2][2], B1[2][2];
    const char* cA = (const char*)g.A + (size_t)cur.pm * tstep; const char* cB = (const char*)g.Bt + (size_t)cur.pn * tstep;
    S.a_ready(cur);
    if constexpr (SP2) {
        PG8_STAGE(PG8_SB(0, 0), cB, voffB); PG8_STAGE(PG8_SB(0, 1), cB + hstep, voffB); PG8_STAGE(PG8_SA(0, 0), cA, voffA); PG8_STAGE(PG8_SA(0, 1), cA + hstep, voffA);
        if (wr == 1) PG8_BAR;
        PG8_WAIT_V(2); PG8_BAR;
        PG8_STAGE(PG8_SB(1, 0), cB + kstep, voffB); PG8_STAGE(PG8_SA(1, 0), cA + kstep, voffA); PG8_STAGE(PG8_SB(1, 1), cB + hstep + kstep, voffB);
        PG8_WAIT_V(6); PG8_BAR;
    } else {
        PG8_STAGE(PG8_SB(0, 0), cB, voffB); PG8_STAGE(PG8_SA(0, 0), cA, voffA); PG8_STAGE(PG8_SB(0, 1), cB + hstep, voffB); PG8_STAGE(PG8_SA(0, 1), cA + hstep, voffA);
        if (wr == 1) PG8_BAR;
        PG8_WAIT_V(4); PG8_BAR;
        PG8_STAGE(PG8_SB(1, 0), cB + kstep, voffB); PG8_STAGE(PG8_SA(1, 0), cA + kstep, voffA); PG8_STAGE(PG8_SB(1, 1), cB + hstep + kstep, voffB);
        PG8_WAIT_V(6); PG8_BAR;
    }
    for (;;) {
        const bool has_next = S.next(ui + 1, nxt);
        const char* nA = has_next ? (const char*)g.A + (size_t)nxt.pm * tstep : cA; const char* nB = has_next ? (const char*)g.Bt + (size_t)nxt.pn * tstep : cB;
        for (int t = 0; t < nt; t += 2) {
            const bool last = (t == nt - 2);
            const char* a1 = cA + (size_t)(t + 1) * kstep;
            const char* a2 = last ? nA : cA + (size_t)(t + 2) * kstep; const char* b2 = last ? nB : cB + (size_t)(t + 2) * kstep;
            const char* a3 = a2 + kstep; const char* b3 = b2 + kstep;
            if (last && has_next) S.a_ready(nxt);
            if constexpr (SP2) {
            PG8_LDB(B0, 0, 0); PG8_LDB(B1, 0, 1); PG8_SCHED; PG8_LDA(At, 0, 0); PG8_STAGE(PG8_SA(1, 1), a1 + hstep, voffA);
            PG8_WAIT_V(8); PG8_WAIT_L(0); PG8_BAR; PG8_MMA(0, 0, At, B0); PG8_MMA(0, 1, At, B1); PG8_BAR; PG8_SCHED;
            PG8_LDA(At, 0, 1); PG8_STAGE(PG8_SB(0, 0), b2, voffB); PG8_STAGE(PG8_SB(0, 1), b2 + hstep, voffB); PG8_STAGE(PG8_SA(0, 0), a2, voffA);
            PG8_WAIT_V(8); PG8_WAIT_L(0); PG8_BAR; PG8_MMA(1, 0, At, B0); PG8_MMA(1, 1, At, B1); PG8_BAR; PG8_SCHED;
            PG8_LDB(B0, 1, 0); PG8_LDB(B1, 1, 1); PG8_SCHED; PG8_LDA(At, 1, 0); PG8_STAGE(PG8_SA(0, 1), a2 + hstep, voffA);
            PG8_WAIT_V(8); PG8_WAIT_L(0); PG8_BAR; PG8_MMA(0, 0, At, B0); PG8_MMA(0, 1, At, B1); PG8_BAR; PG8_SCHED;
            PG8_LDA(At, 1, 1); PG8_STAGE(PG8_SB(1, 0), b3, voffB); PG8_STAGE(PG8_SB(1, 1), b3 + hstep, voffB); PG8_STAGE(PG8_SA(1, 0), a3, voffA);
            PG8_WAIT_V(8); PG8_WAIT_L(0); PG8_BAR; PG8_MMA(1, 0, At, B0); PG8_MMA(1, 1, At, B1); PG8_BAR; PG8_SCHED;
            } else {
            PG8_LDB(B0, 0, 0); PG8_SCHED; PG8_LDA(At, 0, 0); PG8_STAGE(PG8_SA(1, 1), a1 + hstep, voffA);
            PG8_WAIT_L(8); PG8_BAR; PG8_WAIT_L(0); PG8_MMA(0, 0, At, B0); PG8_BAR; PG8_SCHED;
            PG8_LDB(B1, 0, 1); PG8_STAGE(PG8_SB(0, 0), b2, voffB);
            PG8_BAR; PG8_WAIT_L(0); PG8_MMA(0, 1, At, B1); PG8_BAR;
            PG8_LDA(At, 0, 1); PG8_STAGE(PG8_SA(0, 0), a2, voffA);
            PG8_BAR; PG8_WAIT_L(0); PG8_MMA(1, 0, At, B0); PG8_BAR; PG8_SCHED;
            PG8_STAGE(PG8_SB(0, 1), b2 + hstep, voffB);
            PG8_WAIT_V(6); PG8_BAR; PG8_MMA(1, 1, At, B1); PG8_BAR;
            PG8_LDB(B0, 1, 0); PG8_SCHED; PG8_LDA(At, 1, 0); PG8_STAGE(PG8_SA(0, 1), a2 + hstep, voffA);
            PG8_WAIT_L(8); PG8_BAR; PG8_WAIT_L(0); PG8_MMA(0, 0, At, B0); PG8_BAR; PG8_SCHED;
            PG8_LDB(B1, 1, 1); PG8_STAGE(PG8_SB(1, 0), b3, voffB);
            PG8_BAR; PG8_WAIT_L(0); PG8_MMA(0, 1, At, B1); PG8_BAR;
            PG8_LDA(At, 1, 1); PG8_STAGE(PG8_SA(1, 0), a3, voffA);
            PG8_BAR; PG8_WAIT_L(0); PG8_MMA(1, 0, At, B0); PG8_BAR; PG8_SCHED;
            PG8_STAGE(PG8_SB(1, 1), b3 + hstep, voffB);
            PG8_WAIT_V(6); PG8_BAR; PG8_MMA(1, 1, At, B1); PG8_BAR;
            }
        }
        if constexpr (ALIGN_EPI) { if (wr == 0) PG8_BAR; }
        if constexpr (!Epi::AFTER_DRAIN) { E(acc, cur, wr, wc, fr, fq); S.done(cur); }
        if (!has_next) break;
#pragma unroll
        for (int a = 0; a < 2; ++a)
#pragma unroll
            for (int b = 0; b < 2; ++b)
#pragma unroll
                for (int m = 0; m < 4; ++m)
#pragma unroll
                    for (int n = 0; n < 2; ++n) acc[a][b][m][n] = (f32x4){0.f, 0.f, 0.f, 0.f};
        cur = nxt; cA = nA; cB = nB; ++ui;
        if constexpr (ALIGN_EPI) { if (wr == 1) PG8_BAR; }
    }
    PG8_WAIT_V(0);
    if constexpr (!ALIGN_EPI) { if (wr == 0) PG8_BAR; }
    PG8_BAR;
    if constexpr (Epi::AFTER_DRAIN) { E.fused(acc, cur, wr, wc, fr, fq, lds, wid, lane); S.done(cur); }
#undef PG8_SA
#undef PG8_SB
#undef PG8_STAGE
#undef PG8_LDA
#undef PG8_LDB
#undef PG8_MMA
#undef PG8_WAIT_V
#undef PG8_WAIT_L
#undef PG8_BAR
#undef PG8_SCHED
}
}
#define LAS __attribute__((address_space(3)))
typedef unsigned short bf16;
typedef float f32x4 __attribute__((ext_vector_type(4)));
typedef short bf16x8 __attribute__((ext_vector_type(8)));
typedef unsigned v4u __attribute__((ext_vector_type(4)));
typedef unsigned v2u __attribute__((ext_vector_type(2)));
constexpr int DM = 1024, NB = 8, SEQ = 2048, MT = NB * SEQ, DFF = 2816, NG = 32, NCH = 129;
constexpr float RMS_EPS = 1e-6f;
enum { I_X = 0, I_META, I_F1PRE, I_F1POST, I_F1WG, I_F1WU, I_F1WD, I_MIXPRE, I_WIN, I_RPB, I_LRE, I_LIM, I_LOGDT, I_BRE, I_BIM, I_CRE, I_CIM, I_S5D, I_WGLU, I_BGLU,
       I_NAG, I_S5G, I_WOUT, I_MIXPOST, I_F2PRE, I_F2POST, I_F2WG, I_F2WU, I_F2WD, I_FINAL, N_IN };
constexpr size_t KiB = 1024, MiB = 1u << 20;
constexpr size_t WS_META = 1 * MiB;
constexpr size_t OM_A1 = 0, OM_ACT = 32 * KiB, OM_F = 128 * KiB, OM_A2 = 192 * KiB, OM_K = 224 * KiB, OM_U = 240 * KiB, OM_VT = 256 * KiB;
constexpr size_t WS_WGU1 = 2 * MiB, WS_WD1 = 13 * MiB, WS_WQKU = 18 * MiB + 512 * KiB, WS_WV = 21 * MiB + 512 * KiB, WS_WGLU = 22 * MiB + 512 * KiB, WS_WOUT = 23 * MiB,
                 WS_WGU2 = 25 * MiB, WS_WD2 = 36 * MiB, WS_WS = 41 * MiB + 512 * KiB, WS_WY = 45 * MiB + 512 * KiB;
constexpr size_t WS_A = 54 * MiB, WS_H = 86 * MiB, WS_ACT = 150 * MiB;
constexpr size_t WS_Q = 150 * MiB, WS_K = 166 * MiB, WS_U = 182 * MiB, WS_VT = 198 * MiB, WS_YG = 214 * MiB, WS_END = 238 * MiB;
constexpr size_t OUT_S = 0, OUT_XX = 33 * MiB;
constexpr int LDS_BYTES = 147456;
constexpr int NWAVES = 8;

__device__ __forceinline__ unsigned f2bf(float f) { unsigned u = __builtin_bit_cast(unsigned, f); return (u + 0x7fffu + ((u >> 16) & 1u)) >> 16; }
__device__ __forceinline__ unsigned pk2(float lo, float hi) { return f2bf(lo) | (f2bf(hi) << 16); }
__device__ __forceinline__ float bflo(unsigned w) { return __uint_as_float(w << 16); }
__device__ __forceinline__ float bfhi(unsigned w) { return __uint_as_float(w & 0xffff0000u); }
__device__ __forceinline__ float wave_sum(float v) {
#pragma unroll
    for (int o = 1; o < 64; o <<= 1) v += __shfl_xor(v, o);
    return v;
}
__device__ __forceinline__ float dot4(f32x4 a) { return (a.x * a.x + a.y * a.y) + (a.z * a.z + a.w * a.w); }
#define MFMA16(a, b, c) __builtin_amdgcn_mfma_f32_16x16x32_bf16((a), (b), (c), 0, 0, 0)

struct Args { const float* in[N_IN]; float* out; unsigned char* ws; };

__device__ __forceinline__ void tr_item(const float* __restrict__ W, int K, int N, int k0, int n0, bf16* __restrict__ dst, LAS float* scr, int lane) {
#pragma unroll 8
    for (int i = 0; i < 32; ++i) { const int kk = 2 * i + (lane >> 5); scr[kk * 33 + (lane & 31)] = W[(size_t)(k0 + kk) * N + n0 + (lane & 31)]; }
    asm volatile("s_waitcnt lgkmcnt(0)" ::: "memory");
    const int c = lane & 7;
#pragma unroll
    for (int j = 0; j < 4; ++j) { const int n = (lane >> 3) + 8 * j; const LAS float* s = scr + (8 * c) * 33 + n;
        v4u o; o.x = pk2(s[0 * 33], s[1 * 33]); o.y = pk2(s[2 * 33], s[3 * 33]); o.z = pk2(s[4 * 33], s[5 * 33]); o.w = pk2(s[6 * 33], s[7 * 33]);
        *(v4u*)(dst + (size_t)n * K + k0 + 8 * c) = o; }
    asm volatile("s_waitcnt lgkmcnt(0)" ::: "memory");
}
__device__ __forceinline__ void row_norm_bf16(const float* __restrict__ xrow, const float* __restrict__ g, bf16* __restrict__ arow, int lane) {
    f32x4 v[4]; float ss = 0.f;
#pragma unroll
    for (int j = 0; j < 4; ++j) { v[j] = ((const f32x4*)xrow)[lane + 64 * j]; ss += dot4(v[j]); }
    const float r = 1.0f / sqrtf(wave_sum(ss) * (1.0f / DM) + RMS_EPS);
#pragma unroll
    for (int j = 0; j < 4; ++j) { const f32x4 gg = ((const f32x4*)g)[lane + 64 * j]; const f32x4 o = v[j] * r * gg;
        v2u w; w.x = pk2(o.x, o.y); w.y = pk2(o.z, o.w); ((v2u*)arow)[lane + 64 * j] = w; }
}
__device__ __forceinline__ void row_res_norm(const float* base, const float* f, const float* __restrict__ gpost, float resw, float* hout,
                                             const float* __restrict__ gpre, bf16* aout, float* fout, int lane) {
    f32x4 v[4]; float ss = 0.f;
#pragma unroll
    for (int j = 0; j < 4; ++j) { v[j] = ((const f32x4*)f)[lane + 64 * j]; ss += dot4(v[j]); }
    const float r = resw / sqrtf(wave_sum(ss) * (1.0f / DM) + RMS_EPS);
    float s2 = 0.f;
#pragma unroll
    for (int j = 0; j < 4; ++j) { const f32x4 gg = ((const f32x4*)gpost)[lane + 64 * j]; const f32x4 bb = ((const f32x4*)base)[lane + 64 * j];
        v[j] = bb + v[j] * r * gg; s2 += dot4(v[j]); if (hout) ((f32x4*)hout)[lane + 64 * j] = v[j]; }
    const float r2 = 1.0f / sqrtf(wave_sum(s2) * (1.0f / DM) + RMS_EPS);
#pragma unroll
    for (int j = 0; j < 4; ++j) { const f32x4 gg = ((const f32x4*)gpre)[lane + 64 * j]; const f32x4 o = v[j] * r2 * gg;
        if (aout) { v2u w; w.x = pk2(o.x, o.y); w.y = pk2(o.z, o.w); ((v2u*)aout)[lane + 64 * j] = w; }
        if (fout) ((f32x4*)fout)[lane + 64 * j] = o; }
}

__device__ __forceinline__ void s5_prep_group(const Args& a, int g, LAS float* L, int tid) {
    LAS float* PWr = L; LAS float* PWi = PWr + 2176; LAS float* BBr = PWi + 2176; LAS float* BBi = BBr + 2048; LAS float* Cr = BBi + 2048; LAS float* Ci = Cr + 2048; LAS float* KT = Ci + 2048;
    const float* lre = a.in[I_LRE]; const float* lim = a.in[I_LIM]; const float* ldt = a.in[I_LOGDT];
    const float* bre = a.in[I_BRE]; const float* bim = a.in[I_BIM]; const float* cre = a.in[I_CRE]; const float* cim = a.in[I_CIM]; const float* dsk = a.in[I_S5D];
    if (tid < 128) {
        const int dir = tid >> 6, p = tid & 63; const int gi = dir * NG + g;
        const float dt = expf(ldt[gi]); const float lr = lre[gi * 64 + p], li = lim[gi * 64 + p];
        for (int k = 0; k <= 16; ++k) { const float mag = expf((float)k * lr * dt); float sn, cs; sincosf((float)k * li * dt, &sn, &cs);
            PWr[(dir * 17 + k) * 64 + p] = mag * cs; PWi[(dir * 17 + k) * 64 + p] = mag * sn; }
        const float aa = lr * dt, th = li * dt; float sn, cs; sincosf(th, &sn, &cs); const float sh = sinf(0.5f * th);
        const float nr = expm1f(aa) * cs - 2.0f * sh * sh, ni = expf(aa) * sn;
        const float d2 = lr * lr + li * li; const float cr_ = (nr * lr + ni * li) / d2, ci_ = (ni * lr - nr * li) / d2;
        for (int h = 0; h < 16; ++h) { const float br = bre[(gi * 64 + p) * 16 + h], bi = bim[(gi * 64 + p) * 16 + h];
            BBr[(dir * 64 + p) * 16 + h] = cr_ * br - ci_ * bi; BBi[(dir * 64 + p) * 16 + h] = cr_ * bi + ci_ * br; }
    }
    for (int e = tid; e < 2048; e += 512) { const int dir = e >> 10, h = (e >> 6) & 15, p = e & 63; const int gi = dir * NG + g;
        Cr[e] = cre[(gi * 16 + h) * 64 + p]; Ci[e] = cim[(gi * 16 + h) * 64 + p]; }
    __syncthreads();
    {
        const int dir = tid >> 8, lag = (tid >> 4) & 15, h = tid & 15; float acc[16];
#pragma unroll
        for (int q = 0; q < 16; ++q) acc[q] = 0.f;
        for (int p = 0; p < 64; ++p) { const float c_r = Cr[(dir * 16 + h) * 64 + p], c_i = Ci[(dir * 16 + h) * 64 + p], w_r = PWr[(dir * 17 + lag) * 64 + p], w_i = PWi[(dir * 17 + lag) * 64 + p];
            const float zr = c_r * w_r - c_i * w_i, zi = c_r * w_i + c_i * w_r;
#pragma unroll
            for (int q = 0; q < 16; ++q) acc[q] += zr * BBr[(dir * 64 + p) * 16 + q] - zi * BBi[(dir * 64 + p) * 16 + q]; }
#pragma unroll
        for (int q = 0; q < 16; ++q) KT[((dir * 16 + lag) * 16 + h) * 16 + q] = acc[q];
    }
    __syncthreads();
    bf16* WY = (bf16*)(a.ws + WS_WY) + (size_t)g * 256 * 512; bf16* WSg = (bf16*)(a.ws + WS_WS) + (size_t)g * 256 * 256;
    for (int ch = tid; ch < 256 * 64; ch += 512) {
        const int m = ch >> 6, k0 = (ch & 63) * 8; const int t = m >> 4, h = m & 15; float v[8];
        if (k0 < 256) { const int j = k0 >> 4, hb = k0 & 15;
#pragma unroll
            for (int e = 0; e < 8; ++e) { const int hp = hb + e; float x;
                if (j < t) x = KT[((0 * 16 + (t - j)) * 16 + h) * 16 + hp]; else if (j > t) x = KT[((1 * 16 + (j - t)) * 16 + h) * 16 + hp];
                else { x = KT[((0 * 16 + 0) * 16 + h) * 16 + hp] + KT[((1 * 16 + 0) * 16 + h) * 16 + hp]; if (hp == h) x += dsk[g * 16 + h]; }
                v[e] = x; }
        } else { const int kk = k0 - 256; const int dir = kk >> 7, ri = (kk >> 6) & 1, pb = kk & 63; const int ex = dir == 0 ? t + 1 : 16 - t;
#pragma unroll
            for (int e = 0; e < 8; ++e) { const int p = pb + e; const float c_r = Cr[(dir * 16 + h) * 64 + p], c_i = Ci[(dir * 16 + h) * 64 + p], w_r = PWr[(dir * 17 + ex) * 64 + p], w_i = PWi[(dir * 17 + ex) * 64 + p];
                v[e] = ri == 0 ? (c_r * w_r - c_i * w_i) : -(c_r * w_i + c_i * w_r); }
        }
        v4u o; o.x = pk2(v[0], v[1]); o.y = pk2(v[2], v[3]); o.z = pk2(v[4], v[5]); o.w = pk2(v[6], v[7]);
        *(v4u*)(WY + (size_t)m * 512 + k0) = o;
    }
    for (int ch = tid; ch < 256 * 32; ch += 512) {
        const int m = ch >> 5, k0 = (ch & 31) * 8; const int dir = m >> 7, ri = (m >> 6) & 1, p = m & 63; const int j = k0 >> 4, hb = k0 & 15; const int ex = dir == 0 ? 15 - j : j;
        const float w_r = PWr[(dir * 17 + ex) * 64 + p], w_i = PWi[(dir * 17 + ex) * 64 + p]; float v[8];
#pragma unroll
        for (int e = 0; e < 8; ++e) { const float b_r = BBr[(dir * 64 + p) * 16 + hb + e], b_i = BBi[(dir * 64 + p) * 16 + hb + e]; v[e] = ri == 0 ? (w_r * b_r - w_i * b_i) : (w_r * b_i + w_i * b_r); }
        v4u o; o.x = pk2(v[0], v[1]); o.y = pk2(v[2], v[3]); o.z = pk2(v[4], v[5]); o.w = pk2(v[6], v[7]);
        *(v4u*)(WSg + (size_t)m * 256 + k0) = o;
    }
    __syncthreads();
}

template <int NT>
__device__ __forceinline__ void skinny16(const bf16* __restrict__ A, int K, const bf16* __restrict__ B0, const bf16* __restrict__ B1, f32x4& c0, f32x4& c1, int lane) {
    const int fr = lane & 15, fq = lane >> 4;
    const bf16* ap = A + (size_t)fr * K + 8 * fq; const bf16* bp0 = B0 + (size_t)fr * K + 8 * fq; const bf16* bp1 = B1 + (size_t)fr * K + 8 * fq;
    c0 = (f32x4){0.f, 0.f, 0.f, 0.f}; c1 = c0;
#pragma unroll 8
    for (int s = 0; s < K / 32; ++s) { const bf16x8 av = *(const bf16x8*)(ap + 32 * s); const bf16x8 b0 = *(const bf16x8*)(bp0 + 32 * s);
        c0 = MFMA16(av, b0, c0);
        if (NT == 2) { const bf16x8 b1 = *(const bf16x8*)(bp1 + 32 * s); c1 = MFMA16(av, b1, c1); } }
}

__device__ __forceinline__ bf16x8 pack8(f32x4 lo, f32x4 hi) { v4u w; w.x = pk2(lo.x, lo.y); w.y = pk2(lo.z, lo.w); w.z = pk2(hi.x, hi.y); w.w = pk2(hi.z, hi.w); return __builtin_bit_cast(bf16x8, w); }
__device__ __forceinline__ void na_job(int jid, int lane, const bf16* __restrict__ Q, const bf16* __restrict__ Kb, const bf16* __restrict__ Vt, const bf16* __restrict__ Km, const bf16* __restrict__ Vtm,
                                       const float* __restrict__ rpb, bf16* __restrict__ Ona) {
    const int j = jid & 3, r = (jid >> 2) & 31, h = (jid >> 7) & 7, b = jid >> 10;
    const int fr = lane & 15, fq = lane >> 4;
    const int rs = min(max(r - 4, 0), 24), c0 = min(max(16 * j - 8, 0), 32), cq = 16 * j + fr, cs = min(max(cq - 8, 0), 48);
    const size_t qtok = (size_t)b * SEQ + r * 64 + cq;
    const bf16x8 qf0 = *(const bf16x8*)(Q + qtok * 512 + h * 64 + 8 * fq), qf1 = *(const bf16x8*)(Q + qtok * 512 + h * 64 + 32 + 8 * fq);
    f32x4 sc[8][2], scm;
    const f32x4 z4 = (f32x4){0.f, 0.f, 0.f, 0.f};
#pragma unroll
    for (int kr = 0; kr < 8; ++kr)
#pragma unroll
        for (int t = 0; t < 2; ++t) { const int kc = c0 + 8 * (fr >> 2) + 4 * t + (fr & 3); const size_t tok = (size_t)b * SEQ + (rs + kr) * 64 + kc;
            const bf16x8 k0 = *(const bf16x8*)(Kb + tok * 512 + h * 64 + 8 * fq), k1 = *(const bf16x8*)(Kb + tok * 512 + h * 64 + 32 + 8 * fq);
            f32x4 acc = MFMA16(k0, qf0, z4); sc[kr][t] = MFMA16(k1, qf1, acc); }
    { const bf16x8 k0 = *(const bf16x8*)(Km + fr * 512 + h * 64 + 8 * fq), k1 = *(const bf16x8*)(Km + fr * 512 + h * 64 + 32 + 8 * fq);
      f32x4 acc = MFMA16(k0, qf0, z4); scm = MFMA16(k1, qf1, acc); }
    float mx = -3.0e38f;
    const float* rp = rpb + h * 15 * 31;
#pragma unroll
    for (int kr = 0; kr < 8; ++kr) { const int dr = rs + kr - r + 7;
#pragma unroll
        for (int t = 0; t < 2; ++t)
#pragma unroll
            for (int i = 0; i < 4; ++i) { const int kc = c0 + 8 * fq + 4 * t + i; const bool valid = (kc >= cs) && (kc < cs + 16); const int dc = min(max(kc - cq + 15, 0), 30);
                const float s = valid ? sc[kr][t][i] * 0.125f + rp[dr * 31 + dc] : -1.0e30f; sc[kr][t][i] = s; mx = fmaxf(mx, s); } }
#pragma unroll
    for (int i = 0; i < 4; ++i) { scm[i] *= 0.125f; mx = fmaxf(mx, scm[i]); }
    mx = fmaxf(mx, __shfl_xor(mx, 16)); mx = fmaxf(mx, __shfl_xor(mx, 32));
    float sum = 0.f;
#pragma unroll
    for (int kr = 0; kr < 8; ++kr)
#pragma unroll
        for (int t = 0; t < 2; ++t)
#pragma unroll
            for (int i = 0; i < 4; ++i) { const float p = __expf(sc[kr][t][i] - mx); sc[kr][t][i] = p; sum += p; }
#pragma unroll
    for (int i = 0; i < 4; ++i) { const float p = __expf(scm[i] - mx); scm[i] = p; sum += p; }
    sum += __shfl_xor(sum, 16); sum += __shfl_xor(sum, 32);
    const float inv = 1.0f / sum;
    f32x4 o[4] = {z4, z4, z4, z4};
#pragma unroll
    for (int kr = 0; kr < 8; ++kr) { const bf16x8 pb = pack8(sc[kr][0], sc[kr][1]);
        const size_t tok0 = (size_t)b * SEQ + (rs + kr) * 64 + c0 + 8 * fq;
#pragma unroll
        for (int dt = 0; dt < 4; ++dt) { const bf16x8 vf = *(const bf16x8*)(Vt + (size_t)(h * 64 + 16 * dt + fr) * MT + tok0); o[dt] = MFMA16(vf, pb, o[dt]); } }
    { const bf16x8 pb = pack8(scm, z4);
#pragma unroll
      for (int dt = 0; dt < 4; ++dt) { const v2u lo = *(const v2u*)(Vtm + (h * 64 + 16 * dt + fr) * 16 + 4 * fq); v4u w; w.x = lo.x; w.y = lo.y; w.z = 0u; w.w = 0u;
          o[dt] = MFMA16(__builtin_bit_cast(bf16x8, w), pb, o[dt]); } }
#pragma unroll
    for (int dt = 0; dt < 4; ++dt) { const f32x4 v = o[dt] * inv; v2u w; w.x = pk2(v.x, v.y); w.y = pk2(v.z, v.w);
        *(v2u*)(Ona + qtok * 1024 + h * 64 + 16 * dt + 4 * fq) = w; }
}

__device__ __forceinline__ void s5b_job(int jid, int lane, const bf16* __restrict__ U, const bf16* __restrict__ Um, const bf16* __restrict__ WS, float* __restrict__ S) {
    const bool meta = jid >= 2048; const int g = meta ? jid - 2048 : (jid >> 6), nt = jid & 63;
    const int fr = lane & 15, fq = lane >> 4; const int cc = nt * 16 + fr;
    const bf16* ub = meta ? Um + (fq >> 1) * 512 + 16 * g + 8 * (fq & 1) : U + ((size_t)cc * 16 + (fq >> 1)) * 512 + 16 * g + 8 * (fq & 1);
    bf16x8 uf[8];
#pragma unroll
    for (int s = 0; s < 8; ++s) uf[s] = *(const bf16x8*)(ub + (2 * s) * 512);
    const bf16* wp = WS + (size_t)g * 65536 + fr * 256 + 8 * fq;
    const int b = cc >> 7, c = (cc & 127) + 1;
    float* sp = meta ? S + ((size_t)(fr * NCH) * NG + g) * 256 + 4 * fq : S + ((size_t)(b * NCH + c) * NG + g) * 256 + 4 * fq;
    const bool wr = !meta || fr < NB;
#pragma unroll 2
    for (int mt = 0; mt < 16; ++mt) { f32x4 acc = (f32x4){0.f, 0.f, 0.f, 0.f};
#pragma unroll
        for (int s = 0; s < 8; ++s) { const bf16x8 af = *(const bf16x8*)(wp + mt * 4096 + 32 * s); acc = MFMA16(af, uf[s], acc); }
        if (wr) *(f32x4*)(sp + 16 * mt) = acc; }
}
__device__ __forceinline__ void s5c_job(int wid, int lane, const Args& a, const float* __restrict__ S, bf16* __restrict__ XX) {
    const int dir = wid & 1, g = (wid >> 1) & 31, b = wid >> 6, p = lane; const int gi = dir * NG + g;
    const float dt = expf(a.in[I_LOGDT][gi]); const float lr = a.in[I_LRE][gi * 64 + p], li = a.in[I_LIM][gi * 64 + p];
    const float mag = expf(16.0f * lr * dt); float sn, cs; sincosf(16.0f * li * dt, &sn, &cs); const float ar = mag * cs, ai = mag * sn;
    float xr = 0.f, xi = 0.f;
#pragma unroll 8
    for (int st = 0; st < NCH; ++st) { const int c = dir == 0 ? st : NCH - 1 - st; const size_t idx = ((size_t)(b * NCH + c) * NG + g) * 256 + dir * 128 + p;
        XX[idx] = (bf16)f2bf(xr); XX[idx + 64] = (bf16)f2bf(xi);
        const float sr = S[idx], si = S[idx + 64]; const float nr = ar * xr - ai * xi + sr, ni = ar * xi + ai * xr + si; xr = nr; xi = ni; }
}
__device__ __forceinline__ float gelu_tanh(float x) { const float z = 0.7978845608028654f * (x + 0.044715f * x * x * x); const float e = __expf(2.0f * z); const float th = 1.0f - 2.0f / (e + 1.0f); return 0.5f * x * (1.0f + th); }
__device__ __forceinline__ void s5d_job(int jid, int lane, const bf16* __restrict__ U, const bf16* __restrict__ XX, const bf16* __restrict__ WY, bf16* __restrict__ Yg) {
    const int g = jid >> 6, nt = jid & 63; const int fr = lane & 15, fq = lane >> 4; const int cc = nt * 16 + fr; const int b = cc >> 7, c = (cc & 127) + 1;
    const bf16* ub = U + ((size_t)cc * 16 + (fq >> 1)) * 512 + 16 * g + 8 * (fq & 1);
    const bf16* xp = XX + ((size_t)(b * NCH + c) * NG + g) * 256 + 8 * fq;
    bf16x8 uf[8], xf[8];
#pragma unroll
    for (int s = 0; s < 8; ++s) { uf[s] = *(const bf16x8*)(ub + (2 * s) * 512); xf[s] = *(const bf16x8*)(xp + 32 * s); }
    const bf16* wp = WY + (size_t)g * 131072 + fr * 512 + 8 * fq;
#pragma unroll 2
    for (int mt = 0; mt < 16; ++mt) { f32x4 acc = (f32x4){0.f, 0.f, 0.f, 0.f};
#pragma unroll
        for (int s = 0; s < 8; ++s) { const bf16x8 af = *(const bf16x8*)(wp + mt * 8192 + 32 * s); acc = MFMA16(af, uf[s], acc); }
#pragma unroll
        for (int s = 0; s < 8; ++s) { const bf16x8 af = *(const bf16x8*)(wp + mt * 8192 + 256 + 32 * s); acc = MFMA16(af, xf[s], acc); }
        v2u w; w.x = pk2(gelu_tanh(acc.x), gelu_tanh(acc.y)); w.y = pk2(gelu_tanh(acc.z), gelu_tanh(acc.w));
        *(v2u*)(Yg + ((size_t)cc * 16 + mt) * 512 + 16 * g + 4 * fq) = w; }
}
__device__ __forceinline__ void mix_row(bf16* row, const float* __restrict__ gna, const float* __restrict__ gs5, int lane) {
    v4u x0 = ((const v4u*)row)[lane], x1 = ((const v4u*)row)[64 + lane];
    float a[8], c[8];
    a[0] = bflo(x0.x); a[1] = bfhi(x0.x); a[2] = bflo(x0.y); a[3] = bfhi(x0.y); a[4] = bflo(x0.z); a[5] = bfhi(x0.z); a[6] = bflo(x0.w); a[7] = bfhi(x0.w);
    c[0] = bflo(x1.x); c[1] = bfhi(x1.x); c[2] = bflo(x1.y); c[3] = bfhi(x1.y); c[4] = bflo(x1.z); c[5] = bfhi(x1.z); c[6] = bflo(x1.w); c[7] = bfhi(x1.w);
    float s0 = 0.f, s1 = 0.f;
#pragma unroll
    for (int e = 0; e < 8; ++e) { s0 += a[e] * a[e]; s1 += c[e] * c[e]; }
    const float r0 = 1.0f / sqrtf(wave_sum(s0) * (1.0f / 512.0f) + RMS_EPS), r1 = 1.0f / sqrtf(wave_sum(s1) * (1.0f / 512.0f) + RMS_EPS);
    const f32x4 g00 = ((const f32x4*)gna)[2 * lane], g01 = ((const f32x4*)gna)[2 * lane + 1], g10 = ((const f32x4*)gs5)[2 * lane], g11 = ((const f32x4*)gs5)[2 * lane + 1];
    v4u o0, o1;
    o0.x = pk2(a[0] * r0 * g00.x, a[1] * r0 * g00.y); o0.y = pk2(a[2] * r0 * g00.z, a[3] * r0 * g00.w); o0.z = pk2(a[4] * r0 * g01.x, a[5] * r0 * g01.y); o0.w = pk2(a[6] * r0 * g01.z, a[7] * r0 * g01.w);
    o1.x = pk2(c[0] * r1 * g10.x, c[1] * r1 * g10.y); o1.y = pk2(c[2] * r1 * g10.z, c[3] * r1 * g10.w); o1.z = pk2(c[4] * r1 * g11.x, c[5] * r1 * g11.y); o1.w = pk2(c[6] * r1 * g11.z, c[7] * r1 * g11.w);
    ((v4u*)row)[lane] = o0; ((v4u*)row)[64 + lane] = o1;
}
#define XB_TMO      128
#define XB_XCNT(j)  (256  + 64 * (j))
#define XB_XSUB(j)  (1280 + 64 * (j))
#define XB_XGEN(j)  (2304 + 64 * (j))
#define XB_TOP      3328
#define XB_TOPGEN   3392
#define XCD_BAR_WORDS 3456
#define XB_SPIN_CAP (1u << 18)

__device__ __forceinline__ unsigned xb_ld(unsigned* p)              { return __hip_atomic_load(p, __ATOMIC_RELAXED, __HIP_MEMORY_SCOPE_AGENT); }
__device__ __forceinline__ unsigned xb_add(unsigned* p, unsigned v) { return __hip_atomic_fetch_add(p, v, __ATOMIC_RELAXED, __HIP_MEMORY_SCOPE_AGENT); }
__device__ __forceinline__ unsigned xb_xcc_id() { return (unsigned)__builtin_amdgcn_s_getreg((3 << 11) | 20) & 0xFu; }
#define XB_SPIN(cond, bar) do { unsigned _sp = 0; while (cond) { __builtin_amdgcn_s_sleep(1); \
    if ((++_sp & 255u) == 0u) { if (xb_ld(&(bar)[XB_TMO])) break; if (_sp > XB_SPIN_CAP) { atomicAdd(&(bar)[XB_TMO], 1u); break; } } } } while (0)

struct XcdBarrier {
    unsigned* bar; unsigned x;
    volatile LAS unsigned* st;
};

__device__ __forceinline__ XcdBarrier xcd_barrier_post(unsigned* bar, volatile LAS unsigned* st) {
    XcdBarrier b; b.bar = bar; b.x = xb_xcc_id(); b.st = st;
    if (threadIdx.x == 0) (void)xb_add(&bar[XB_XCNT(b.x)], 1u);
    return b;
}
__device__ __forceinline__ void xcd_barrier_complete(unsigned* bar, unsigned x, unsigned& nloc, unsigned& nx) {
    const unsigned G = gridDim.x * gridDim.y * gridDim.z;
    unsigned sum, cnt, mine, sp = 0u;
    for (;;) {
        sum = 0u; cnt = 0u; mine = 0u;
#pragma unroll
        for (unsigned j = 0; j < 16; ++j) { const unsigned c = xb_ld(&bar[XB_XCNT(j)]); sum += c; cnt += (c > 0u) ? 1u : 0u; mine = (j == x) ? c : mine; }
        if (sum == G) break;
        __builtin_amdgcn_s_sleep(1);
        if ((++sp & 255u) == 0u) { if (xb_ld(&bar[XB_TMO])) break; if (sp > XB_SPIN_CAP) { atomicAdd(&bar[XB_TMO], 1u); break; } }
    }
    nloc = mine > 0u ? mine : 1u; nx = cnt > 0u ? cnt : 1u;
}

__device__ __forceinline__ void xcd_barrier(const XcdBarrier& b) {
    asm volatile("s_waitcnt vmcnt(0)" ::: "memory");
    __syncthreads();
    if (threadIdx.x == 0) {
        unsigned* bar = b.bar;
        __builtin_amdgcn_s_waitcnt(0);
        unsigned nloc = b.st[0], nx = b.st[1];
        if (nloc == 0u) { xcd_barrier_complete(bar, b.x, nloc, nx); b.st[0] = nloc; b.st[1] = nx; }
        const unsigned old = xb_add(&bar[XB_XSUB(b.x)], 1u);
        const unsigned gen = old / nloc;
        if (old + 1u == (gen + 1u) * nloc) {
            __builtin_amdgcn_fence(__ATOMIC_RELEASE, "agent");
            asm volatile("s_waitcnt vmcnt(0)" ::: "memory");
            const unsigned og = xb_add(&bar[XB_TOP], 1u);
            const unsigned tg = og / nx;
            if (og + 1u == (tg + 1u) * nx) xb_add(&bar[XB_TOPGEN], 1u);
            else XB_SPIN(xb_ld(&bar[XB_TOPGEN]) == tg, bar);
            __builtin_amdgcn_fence(__ATOMIC_ACQUIRE, "agent");
            xb_add(&bar[XB_XGEN(b.x)], 1u);
            asm volatile("s_waitcnt vmcnt(0)" ::: "memory");
        } else {
            XB_SPIN(xb_ld(&bar[XB_XGEN(b.x)]) == gen, bar);
            __builtin_amdgcn_fence(__ATOMIC_ACQUIRE, "agent");
            asm volatile("s_waitcnt vmcnt(0)" ::: "memory");
        }
    }
    __syncthreads();
}
__global__ void __launch_bounds__(NWAVES * 64, 2) hyb_fwd(Args args) {
    extern __shared__ __attribute__((aligned(16))) unsigned char lds_raw[];
    cg::grid_group grid = cg::this_grid();
    LAS unsigned char* lds = (LAS unsigned char*)lds_raw;
    const int tid = threadIdx.x, lane = tid & 63, wave = __builtin_amdgcn_readfirstlane(tid >> 6);
    const int G = gridDim.x, bx = blockIdx.x;
    const int gw = bx * NWAVES + wave, NGW = G * NWAVES;
    const int sw = wave * G + bx;
    unsigned char* ws = args.ws;
    bf16* A1M = (bf16*)(ws + WS_META + OM_A1); bf16* ACTM = (bf16*)(ws + WS_META + OM_ACT); float* FM = (float*)(ws + WS_META + OM_F); bf16* A2M = (bf16*)(ws + WS_META + OM_A2);
    bf16* KM = (bf16*)(ws + WS_META + OM_K); bf16* UM = (bf16*)(ws + WS_META + OM_U); bf16* VTM = (bf16*)(ws + WS_META + OM_VT);
    bf16* WGU1 = (bf16*)(ws + WS_WGU1); bf16* WD1 = (bf16*)(ws + WS_WD1); bf16* WQKU = (bf16*)(ws + WS_WQKU); bf16* WV = (bf16*)(ws + WS_WV); bf16* WGLU = (bf16*)(ws + WS_WGLU);
    bf16* WOUT = (bf16*)(ws + WS_WOUT); bf16* WGU2 = (bf16*)(ws + WS_WGU2); bf16* WD2 = (bf16*)(ws + WS_WD2); bf16* WSS = (bf16*)(ws + WS_WS); bf16* WY = (bf16*)(ws + WS_WY);
    bf16* AB = (bf16*)(ws + WS_A); float* HB = (float*)(ws + WS_H); bf16* ACT = (bf16*)(ws + WS_ACT);
    bf16* QB = (bf16*)(ws + WS_Q); bf16* KB = (bf16*)(ws + WS_K); bf16* VT = (bf16*)(ws + WS_VT); bf16* UB = (bf16*)(ws + WS_U); bf16* YG = (bf16*)(ws + WS_YG);
    float* FO = args.out;
    float* SS = (float*)((unsigned char*)args.out + OUT_S); bf16* XX = (bf16*)((unsigned char*)args.out + OUT_XX);
    const float* X = args.in[I_X];
    if (tid < 2) ((volatile LAS unsigned*)(lds + 131072))[tid] = 0u;
    __syncthreads();
    const XcdBarrier xbar = xcd_barrier_post((unsigned*)ws, (volatile LAS unsigned*)(lds + 131072));
    if (args.ws == nullptr) grid.sync();
#define GSYNC() do { for (int rep_ = 0; rep_ < 1 + PROBE_SYNC; ++rep_) xcd_barrier(xbar); } while (0)

    if (bx < NG) s5_prep_group(args, bx, (LAS float*)lds, tid);
    {
        LAS float* scr = (LAS float*)(lds + wave * 16384);
        constexpr int IT_FF = 1408, IT_IN = 1024, IT_GLU = 128, IT_OUT = 512;
        constexpr int NITEMS = 6 * IT_FF + IT_IN + IT_GLU + IT_OUT;
        for (int it = gw; it < NITEMS; it += NGW) {
            int r = it;
            if (r < 2 * IT_FF) { const bool up = r >= IT_FF; if (up) r -= IT_FF; const int kb = r / 88, nb = r % 88, n0 = nb * 32;
                tr_item(args.in[up ? I_F1WU : I_F1WG], 1024, DFF, kb * 64, n0, WGU1 + (size_t)(256 * (n0 >> 7) + (n0 & 127) + (up ? 128 : 0)) * 1024, scr, lane); continue; } r -= 2 * IT_FF;
            if (r < IT_FF) { const int kb = r / 32, nb = r % 32; tr_item(args.in[I_F1WD], DFF, 1024, kb * 64, nb * 32, WD1 + (size_t)(nb * 32) * DFF, scr, lane); continue; } r -= IT_FF;
            if (r < IT_IN) { const int kb = r / 64, nb = r % 64, n0 = nb * 32;
                bf16* dst = n0 < 1024 ? WQKU + (size_t)n0 * 1024 : (n0 < 1536 ? WV + (size_t)(n0 - 1024) * 1024 : WQKU + (size_t)(n0 - 512) * 1024);
                tr_item(args.in[I_WIN], 1024, 2048, kb * 64, n0, dst, scr, lane); continue; } r -= IT_IN;
            if (r < IT_GLU) { const int kb = r / 16, nb = r % 16; tr_item(args.in[I_WGLU], 512, 512, kb * 64, nb * 32, WGLU + (size_t)(nb * 32) * 512, scr, lane); continue; } r -= IT_GLU;
            if (r < IT_OUT) { const int kb = r / 32, nb = r % 32; tr_item(args.in[I_WOUT], 1024, 1024, kb * 64, nb * 32, WOUT + (size_t)(nb * 32) * 1024, scr, lane); continue; } r -= IT_OUT;
            if (r < 2 * IT_FF) { const bool up = r >= IT_FF; if (up) r -= IT_FF; const int kb = r / 88, nb = r % 88, n0 = nb * 32;
                tr_item(args.in[up ? I_F2WU : I_F2WG], 1024, DFF, kb * 64, n0, WGU2 + (size_t)(256 * (n0 >> 7) + (n0 & 127) + (up ? 128 : 0)) * 1024, scr, lane); continue; } r -= 2 * IT_FF;
            { const int kb = r / 32, nb = r % 32; tr_item(args.in[I_F2WD], DFF, 1024, kb * 64, nb * 32, WD2 + (size_t)(nb * 32) * DFF, scr, lane); }
        }
        for (int m = gw; m < MT + 16; m += NGW) {
            if (m < MT) row_norm_bf16(X + (size_t)m * DM, args.in[I_F1PRE], AB + (size_t)m * DM, lane);
            else row_norm_bf16(args.in[I_META] + (size_t)(m - MT) * DM, args.in[I_F1PRE], A1M + (size_t)(m - MT) * DM, lane);
        }
    }
    GSYNC();

    if (sw < 176) { const int pn = sw >> 3, qq = sw & 7; f32x4 c0, c1;
        skinny16<2>(A1M, 1024, WGU1 + (size_t)(256 * pn + 16 * qq) * 1024, WGU1 + (size_t)(256 * pn + 128 + 16 * qq) * 1024, c0, c1, lane);
        const int fr = lane & 15, fq = lane >> 4;
#pragma unroll
        for (int i = 0; i < 4; ++i) ACTM[(4 * fq + i) * DFF + 128 * pn + 16 * qq + fr] = (bf16)f2bf(c0[i] * pg8::fast_sigmoid(c0[i]) * c1[i]); }
    { pg8::Gemm g{AB, WGU1, MT, 2 * DFF, 1024}; pg8::StaticOrder S; S.init(MT, 2 * DFF, G, bx); pg8::EpiSwiGLU E{ACT, DFF};
      pg8::gemm_phase<pg8::EpiSwiGLU, pg8::StaticOrder, true, true>(lds, g, S, E); }
    GSYNC();

    if (sw < 64) { f32x4 c0, c1; skinny16<1>(ACTM, DFF, WD1 + (size_t)(16 * sw) * DFF, WD1, c0, c1, lane); const int fr = lane & 15, fq = lane >> 4;
#pragma unroll
        for (int i = 0; i < 4; ++i) FM[(4 * fq + i) * 1024 + 16 * sw + fr] = c0[i]; }
    { pg8::Gemm g{ACT, WD1, MT, 1024, DFF}; pg8::StaticOrder S; S.init(MT, 1024, G, bx); pg8::EpiF32 E{FO, 1024};
      pg8::gemm_phase<pg8::EpiF32, pg8::StaticOrder, true, true>(lds, g, S, E); }
    GSYNC();

    for (int m = gw; m < MT + 16; m += NGW) {
        if (m < MT) row_res_norm(X + (size_t)m * DM, FO + (size_t)m * DM, args.in[I_F1POST], 0.5f, HB + (size_t)m * DM, args.in[I_MIXPRE], AB + (size_t)m * DM, nullptr, lane);
        else { const int q = m - MT; row_res_norm(args.in[I_META] + (size_t)q * DM, FM + (size_t)q * DM, args.in[I_F1POST], 0.5f, nullptr, args.in[I_MIXPRE], A2M + (size_t)q * DM, nullptr, lane); }
    }
    GSYNC();

    if (sw < 96) { f32x4 c0, c1; const int fr = lane & 15, fq = lane >> 4;
        if (sw < 64) { skinny16<1>(A2M, 1024, WQKU + (size_t)(512 + 16 * sw) * 1024, WQKU, c0, c1, lane);
            bf16* dst = sw < 32 ? KM + 16 * sw : UM + 16 * (sw - 32);
#pragma unroll
            for (int i = 0; i < 4; ++i) dst[(4 * fq + i) * 512 + fr] = (bf16)f2bf(c0[i]); }
        else { const int q = sw - 64; skinny16<1>(A2M, 1024, WV + (size_t)(16 * q) * 1024, WV, c0, c1, lane);
            v2u w; w.x = pk2(c0[0], c0[1]); w.y = pk2(c0[2], c0[3]); *(v2u*)(VTM + (16 * q + fr) * 16 + 4 * fq) = w; } }
    { pg8::Gemm g{AB, WQKU, MT, 1536, 1024}; pg8::StaticOrder S; S.init(MT, 1536, G, bx); pg8::EpiBf16<0> E{QB, 512, nullptr, 512, (size_t)MT * 512, 1.f};
      pg8::gemm_phase<pg8::EpiBf16<0>, pg8::StaticOrder, true, true>(lds, g, S, E); }
    { const bool trick = (G == 256);
      if (!trick || bx >= 128) { pg8::Gemm g{WV, AB, 512, MT, 1024}; pg8::StaticOrder S; S.init(512, MT, G, trick ? bx - 128 : bx); pg8::EpiBf16<0> E{VT, MT, nullptr, 0, 0, 1.f};
          pg8::gemm_phase<pg8::EpiBf16<0>, pg8::StaticOrder, true, true>(lds, g, S, E); } }
    GSYNC();

    for (int rep = 0; rep < 1 + PROBE_S5B; ++rep)
    for (int j = gw; j < 2080; j += NGW) s5b_job(j, lane, UB, UM, WSS, SS);
    for (int rep = 0; rep < 1 + PROBE_NA; ++rep)
    for (int j = gw; j < 8192; j += NGW) na_job(j, lane, QB, KB, VT, KM, VTM, args.in[I_RPB], AB);
    GSYNC();

    for (int rep = 0; rep < 1 + PROBE_S5C; ++rep)
    for (int j = sw; j < 512; j += NGW) s5c_job(j, lane, args, SS, XX);
    GSYNC();

    for (int rep = 0; rep < 1 + PROBE_S5D; ++rep)
    for (int j = gw; j < 2048; j += NGW) s5d_job(j, lane, UB, XX, WY, YG);
    GSYNC();

    { pg8::Gemm g{YG, WGLU, MT, 512, 512}; pg8::StaticOrder S; S.init(MT, 512, G, bx); pg8::EpiGLU E{YG, 512, args.in[I_BGLU], AB + 512, 1024};
      pg8::gemm_phase<pg8::EpiGLU, pg8::StaticOrder, true, true>(lds, g, S, E); }
    GSYNC();

    for (int m = gw; m < MT; m += NGW) mix_row(AB + (size_t)m * DM, args.in[I_NAG], args.in[I_S5G], lane);
    GSYNC();

    { pg8::Gemm g{AB, WOUT, MT, 1024, 1024}; pg8::StaticOrder S; S.init(MT, 1024, G, bx); pg8::EpiF32 E{FO, 1024};
      pg8::gemm_phase<pg8::EpiF32, pg8::StaticOrder, true, true>(lds, g, S, E); }
    GSYNC();

    for (int m = gw; m < MT; m += NGW) row_res_norm(HB + (size_t)m * DM, FO + (size_t)m * DM, args.in[I_MIXPOST], 1.0f, HB + (size_t)m * DM, args.in[I_F2PRE], AB + (size_t)m * DM, nullptr, lane);
    GSYNC();

    { pg8::Gemm g{AB, WGU2, MT, 2 * DFF, 1024}; pg8::StaticOrder S; S.init(MT, 2 * DFF, G, bx); pg8::EpiSwiGLU E{ACT, DFF};
      pg8::gemm_phase<pg8::EpiSwiGLU, pg8::StaticOrder, true, true>(lds, g, S, E); }
    GSYNC();

    { pg8::Gemm g{ACT, WD2, MT, 1024, DFF}; pg8::StaticOrder S; S.init(MT, 1024, G, bx); pg8::EpiF32 E{FO, 1024};
      pg8::gemm_phase<pg8::EpiF32, pg8::StaticOrder, true, true>(lds, g, S, E); }
    GSYNC();

    for (int m = gw; m < MT; m += NGW) row_res_norm(HB + (size_t)m * DM, FO + (size_t)m * DM, args.in[I_F2POST], 0.5f, nullptr, args.in[I_FINAL], nullptr, FO + (size_t)m * DM, lane);
}

extern "C" void kernel_launch(void* const* d_in, const int* in_sizes, int n_in, void* d_out, int out_size, void* d_ws, size_t ws_size, hipStream_t stream) {
    static int grid_blocks = 0;
    if (grid_blocks == 0) {
        if (n_in != N_IN || out_size != MT * DM || ws_size < WS_END) { fprintf(stderr, "kernel_launch: unexpected problem (n_in %d out %d ws %zu)\n", n_in, out_size, ws_size); grid_blocks = -1; return; }
        int dev = 0, cus = 0, per_cu = 0;
        (void)hipGetDevice(&dev); (void)hipDeviceGetAttribute(&cus, hipDeviceAttributeMultiprocessorCount, dev);
        (void)hipFuncSetAttribute((const void*)hyb_fwd, hipFuncAttributeMaxDynamicSharedMemorySize, LDS_BYTES);
        (void)hipOccupancyMaxActiveBlocksPerMultiprocessor(&per_cu, (const void*)hyb_fwd, NWAVES * 64, LDS_BYTES);
        if (per_cu < 1) { fprintf(stderr, "kernel_launch: occupancy query reports %d blocks per CU\n", per_cu); per_cu = 1; }
        (void)hipGetLastError();
        grid_blocks = cus;
    }
    if (grid_blocks < 0) return;
    if (hipMemsetAsync(d_ws, 0, 16384, stream) != hipSuccess) { fprintf(stderr, "kernel_launch: memset failed\n"); return; }
    Args a{};
    for (int i = 0; i < N_IN; ++i) a.in[i] = (const float*)d_in[i];
    a.out = (float*)d_out; a.ws = (unsigned char*)d_ws;
    void* kargs[] = {&a};
    hipError_t e = hipLaunchCooperativeKernel((const void*)hyb_fwd, dim3(grid_blocks), dim3(NWAVES * 64), kargs, LDS_BYTES, stream);
    if (e != hipSuccess) fprintf(stderr, "cooperative launch failed: %s (grid %d)\n", hipGetErrorString(e), grid_blocks);
}
```
